# Optimizing an MI355X kernel written in HIP

```python
import math
import jax
import jax.numpy as jnp
from jax import lax
import numpy as np

D_MODEL = 2048
BATCH = 8
SEQ = 2048
DEPTH = 2

EPS = 1e-6
Q_BLOCK = 128
REL_BUCKETS = 32
REL_MAX_DIST = 128
REL_HEADS = 8

A_HEADS = 8
A_DH = 64
A_DV = 2 * A_DH

B_HEADS = 8
B_DK = 64
B_DV = 128
RET_CHUNK = 128
ROPE_BASE = 10000.0

C_DINNER = D_MODEL
C_HEADDIM = 64
C_HEADS = C_DINNER // C_HEADDIM
C_GROUPS = 4
C_DSTATE = 128
C_CONV = 4
C_CONV_CH = C_DINNER + 2 * C_GROUPS * C_DSTATE
SSD_CHUNK = 128

D_HEADS = 8
D_DH = 128
D_LATENT = 256
IDX_HEADS = 16
IDX_DIM = 64
IDX_TOPK_MAX = 256

PEER_HEADS = 8
PEER_NKEYS = 128
PEER_NEXPERTS = PEER_NKEYS * PEER_NKEYS
PEER_DQ = 256
PEER_TOPK = 16
PEER_CHUNK = 128

AB_WIDTHS = (A_HEADS * 2 * A_DH, A_HEADS * 2 * A_DH, A_HEADS * A_DV,
             B_HEADS * B_DK, B_HEADS * B_DK, B_HEADS * B_DV, B_HEADS * B_DV)
AB_IN = sum(AB_WIDTHS)
AB_MIX = A_HEADS * A_DV + B_HEADS * B_DV
CD_WIDTHS = (C_DINNER, C_CONV_CH, C_HEADS,
             D_HEADS * D_DH, D_LATENT, IDX_HEADS * IDX_DIM, IDX_DIM, IDX_HEADS)
CD_IN = sum(CD_WIDTHS)
CD_MIX = C_DINNER + D_HEADS * D_DH

kernel_name = 'hybrid_diffret_ssd_dsa_peer'


def rms_f32(x, g):
    xf = x.astype(jnp.float32)
    return xf * lax.rsqrt(jnp.mean(xf * xf, axis=-1, keepdims=True) + EPS) * g.astype(jnp.float32)


def rmsnorm(x, g):
    return rms_f32(x, g).astype(x.dtype)


def split_cols(a, widths):
    offs = np.cumsum(widths)[:-1].tolist()
    return jnp.split(a, offs, axis=-1)


def to_blocks(a, size):
    return a.reshape(a.shape[0], a.shape[1] // size, size, *a.shape[2:]).swapaxes(0, 1)


def from_blocks(a):
    a = a.swapaxes(0, 1)
    return a.reshape(a.shape[0], a.shape[1] * a.shape[2], *a.shape[3:])


def rel_bucket(dist):
    n = jnp.maximum(dist, 0)
    max_exact = REL_BUCKETS // 2
    nf = jnp.maximum(n, 1).astype(jnp.float32)
    large = max_exact + (jnp.log(nf / max_exact) / math.log(REL_MAX_DIST / max_exact)
                         * (REL_BUCKETS - max_exact)).astype(jnp.int32)
    large = jnp.minimum(large, REL_BUCKETS - 1)
    return jnp.where(n < max_exact, n, large)


def rope(x, pos):
    d = x.shape[-1]
    inv = ROPE_BASE ** (-jnp.arange(0, d, 2, dtype=jnp.float32) / d)
    ang = pos.astype(jnp.float32)[:, None] * inv[None, :]
    cos = jnp.cos(ang)[None, :, None, :]
    sin = jnp.sin(ang)[None, :, None, :]
    xf = x.astype(jnp.float32)
    x1, x2 = xf[..., 0::2], xf[..., 1::2]
    return jnp.stack([x1 * cos - x2 * sin, x1 * sin + x2 * cos], axis=-1).reshape(x.shape).astype(x.dtype)


def diff_attention(q, k, v, lam, rel_table):
    bsz, s_len = q.shape[0], q.shape[1]
    nb = s_len // Q_BLOCK
    kpos = jnp.arange(s_len)
    scale = A_DH ** -0.5

    def block(args):
        qblk, i = args
        qpos = i * Q_BLOCK + jnp.arange(Q_BLOCK)
        dist = qpos[:, None] - kpos[None, :]
        bias = rel_table[rel_bucket(dist)].astype(jnp.float32).transpose(2, 0, 1)
        bias = jnp.where((dist >= 0)[None], bias, -jnp.inf)
        logits = jnp.einsum('bqhmd,bshmd->bmhqs', qblk, k).astype(jnp.float32) * scale + bias[None, None]
        p = jax.nn.softmax(logits, axis=-1)
        w = p[:, 0] - lam * p[:, 1]
        return jnp.einsum('bhqs,bshd->bqhd', w.astype(v.dtype), v)

    out = lax.map(block, (to_blocks(q, Q_BLOCK), jnp.arange(nb)))
    return from_blocks(out)


def retention(q, k, v):
    bsz, s_len, n_h, dk = q.shape
    dv = v.shape[-1]
    c = RET_CHUNK
    log_gamma = jnp.log(1.0 - 2.0 ** (-5.0 - jnp.arange(n_h, dtype=jnp.float32)))
    idx = jnp.arange(c, dtype=jnp.float32)
    rel = idx[:, None] - idx[None, :]
    inner_decay = jnp.where(rel[None] >= 0, jnp.exp(rel[None] * log_gamma[:, None, None]), 0.0)
    q_decay = jnp.exp((idx[:, None] + 1.0) * log_gamma[None, :])
    k_decay = jnp.exp((c - 1.0 - idx[:, None]) * log_gamma[None, :])
    chunk_decay = jnp.exp(c * log_gamma)
    qc = to_blocks(q.astype(jnp.float32) * dk ** -0.5, c)
    kc = to_blocks(k.astype(jnp.float32), c)
    vc = to_blocks(v.astype(jnp.float32), c)

    def step(state, inp):
        qi, ki, vi = inp
        scores = jnp.einsum('bqhd,bshd->bhqs', qi, ki) * inner_decay[None]
        o = jnp.einsum('bhqs,bshv->bqhv', scores, vi)
        o = o + jnp.einsum('bqhd,bhdv->bqhv', qi * q_decay[None, :, :, None], state)
        state = state * chunk_decay[None, :, None, None] + jnp.einsum(
            'bshd,bshv->bhdv', ki * k_decay[None, :, :, None], vi)
        return state, o

    _, o = lax.scan(step, jnp.zeros((bsz, n_h, dk, dv), jnp.float32), (qc, kc, vc))
    return from_blocks(o)


def causal_dwconv(x, w, b):
    k_w = w.shape[0]
    out = lax.conv_general_dilated(x, w[:, None, :], window_strides=(1,), padding=[(k_w - 1, 0)],
                                   dimension_numbers=('NWC', 'WIO', 'NWC'),
                                   feature_group_count=x.shape[-1])
    return out + b


def ssd_scan(x, dt, a, bm, cm):
    bsz, s_len, n_h, p = x.shape
    g, n = bm.shape[2], bm.shape[3]
    hg = n_h // g
    qn = SSD_CHUNK
    f32 = jnp.float32
    xs = to_blocks(x.astype(f32).reshape(bsz, s_len, g, hg, p), qn)
    dts = to_blocks(dt.reshape(bsz, s_len, g, hg), qn)
    bs = to_blocks(bm.astype(f32), qn)
    cs_in = to_blocks(cm.astype(f32), qn)
    ag = a.reshape(g, hg)
    causal = jnp.tril(jnp.ones((qn, qn), bool))[None, :, :, None, None]

    def step(state, inp):
        xc, dtc, bc, cc = inp
        cs = jnp.cumsum(dtc * ag, axis=1)
        seg = cs[:, :, None] - cs[:, None, :]
        lmat = jnp.exp(jnp.where(causal, seg, -jnp.inf))
        cb = jnp.einsum('blgn,bsgn->blsg', cc, bc)
        xdt = xc * dtc[..., None]
        y = jnp.einsum('blsg,blsgh,bsghp->blghp', cb, lmat, xdt)
        y = y + jnp.einsum('blgn,bghpn->blghp', cc, state) * jnp.exp(cs)[..., None]
        last = cs[:, -1]
        to_end = jnp.exp(last[:, None] - cs)
        state = state * jnp.exp(last)[..., None, None] + jnp.einsum(
            'bsgn,bsghp->bghpn', bc, xdt * to_end[..., None])
        return state, y

    _, y = lax.scan(step, jnp.zeros((bsz, g, hg, p, n), f32), (xs, dts, bs, cs_in))
    return from_blocks(y).reshape(bsz, s_len, n_h, p)


def mamba2_mixer(z, xbc, dt_raw, conv_w, conv_b, dt_bias, a_log, d_skip, norm_g):
    bsz, s_len = z.shape[0], z.shape[1]
    xbc = jax.nn.silu(causal_dwconv(xbc, conv_w, conv_b))
    xs, bm, cm = split_cols(xbc, (C_DINNER, C_GROUPS * C_DSTATE, C_GROUPS * C_DSTATE))
    dt = jax.nn.softplus(dt_raw.astype(jnp.float32) + dt_bias.astype(jnp.float32))
    a = -jnp.exp(a_log.astype(jnp.float32))
    xh = xs.reshape(bsz, s_len, C_HEADS, C_HEADDIM)
    y = ssd_scan(xh, dt, a,
                 bm.reshape(bsz, s_len, C_GROUPS, C_DSTATE),
                 cm.reshape(bsz, s_len, C_GROUPS, C_DSTATE))
    y = y + xh.astype(jnp.float32) * d_skip.astype(jnp.float32)[:, None]
    y = y.reshape(bsz, s_len, C_DINNER) * jax.nn.silu(z.astype(jnp.float32))
    yg = y.reshape(bsz, s_len, C_GROUPS, C_DINNER // C_GROUPS)
    yg = yg * lax.rsqrt(jnp.mean(yg * yg, axis=-1, keepdims=True) + EPS)
    return (yg.reshape(bsz, s_len, C_DINNER) * norm_g.astype(jnp.float32)).astype(z.dtype)


def dsa_mixer(q, ckv, q_idx, k_idx, w_idx, kv_norm, w_uk, w_uv, rel_table):
    bsz, s_len = q.shape[0], q.shape[1]
    topk = min(IDX_TOPK_MAX, s_len // 4)
    nb = s_len // Q_BLOCK
    ckv = rmsnorm(ckv, kv_norm)
    q_abs = jnp.einsum('bshd,hdc->bshc', q, w_uk)
    kpos = jnp.arange(s_len)
    bidx = jnp.arange(bsz)[:, None, None]
    idx_scale = (IDX_HEADS * IDX_DIM) ** -0.5

    def block(args):
        qa, qi, wi, i = args
        qpos = i * Q_BLOCK + jnp.arange(Q_BLOCK)
        causal = qpos[:, None] >= kpos[None, :]
        rel = jax.nn.relu(jnp.einsum('bqhd,bsd->bqhs', qi, k_idx).astype(jnp.float32))
        score = jnp.einsum('bqh,bqhs->bqs', wi.astype(jnp.float32) * idx_scale, rel)
        score = jnp.where(causal[None], score, -jnp.inf)
        _, sel = lax.top_k(score, topk)
        kv_sel = ckv[bidx, sel]
        dist = qpos[None, :, None] - sel
        valid = dist >= 0
        bias = rel_table[rel_bucket(dist)].astype(jnp.float32)
        logits = jnp.einsum('bqhc,bqkc->bqhk', qa, kv_sel).astype(jnp.float32) * D_DH ** -0.5
        logits = logits + bias.transpose(0, 1, 3, 2)
        logits = jnp.where(valid[:, :, None, :], logits, -jnp.inf)
        p = jax.nn.softmax(logits, axis=-1)
        ctx = jnp.einsum('bqhk,bqkc->bqhc', p.astype(kv_sel.dtype), kv_sel)
        return jnp.einsum('bqhc,hcd->bqhd', ctx, w_uv)

    out = lax.map(block, (to_blocks(q_abs, Q_BLOCK), to_blocks(q_idx, Q_BLOCK),
                          to_blocks(w_idx, Q_BLOCK), jnp.arange(nb)))
    return from_blocks(out)


def ab_mixer(h, w_in, w_out, lam_p, a_norm, b_norm, rel_table, layer):
    bsz, s_len, _ = h.shape
    qa, ka, va, qb, kb, vb, gb = split_cols(h @ w_in, AB_WIDTHS)
    lam_init = 0.8 - 0.6 * math.exp(-0.3 * layer)
    lp = lam_p.astype(jnp.float32)
    lam = jnp.exp(jnp.sum(lp[0] * lp[1])) - jnp.exp(jnp.sum(lp[2] * lp[3])) + lam_init
    oa = diff_attention(qa.reshape(bsz, s_len, A_HEADS, 2, A_DH),
                        ka.reshape(bsz, s_len, A_HEADS, 2, A_DH),
                        va.reshape(bsz, s_len, A_HEADS, A_DV), lam, rel_table)
    oa = rms_f32(oa, a_norm) * (1.0 - lam_init)
    pos = jnp.arange(s_len)
    ob = retention(rope(qb.reshape(bsz, s_len, B_HEADS, B_DK), pos),
                   rope(kb.reshape(bsz, s_len, B_HEADS, B_DK), pos),
                   vb.reshape(bsz, s_len, B_HEADS, B_DV))
    ob = rms_f32(ob, b_norm) * jax.nn.silu(gb.astype(jnp.float32)).reshape(bsz, s_len, B_HEADS, B_DV)
    mixed = jnp.concatenate([oa.reshape(bsz, s_len, -1), ob.reshape(bsz, s_len, -1)], axis=-1)
    return mixed.astype(h.dtype) @ w_out


def cd_mixer(h, w_in, w_out, conv_w, conv_b, dt_bias, a_log, d_skip, ssm_norm,
             kv_norm, w_uk, w_uv, rel_table):
    bsz, s_len, _ = h.shape
    z, xbc, dt, q, ckv, q_idx, k_idx, w_idx = split_cols(h @ w_in, CD_WIDTHS)
    yc = mamba2_mixer(z, xbc, dt, conv_w, conv_b, dt_bias, a_log, d_skip, ssm_norm)
    yd = dsa_mixer(q.reshape(bsz, s_len, D_HEADS, D_DH), ckv,
                   q_idx.reshape(bsz, s_len, IDX_HEADS, IDX_DIM), k_idx, w_idx,
                   kv_norm, w_uk, w_uv, rel_table)
    mixed = jnp.concatenate([yc, yd.reshape(bsz, s_len, -1).astype(yc.dtype)], axis=-1)
    return mixed.astype(h.dtype) @ w_out


def peer(h, w_q, sub_keys, u, v):
    bsz, s_len, d = h.shape
    t = bsz * s_len
    ht = h.reshape(t, d)
    q = (ht @ w_q).reshape(t, PEER_HEADS, 2, PEER_DQ // 2)
    s = jnp.einsum('thcd,hckd->thck', q, sub_keys).astype(jnp.float32)
    top_s, top_i = lax.top_k(s, PEER_TOPK)
    cand = (top_s[:, :, 0, :, None] + top_s[:, :, 1, None, :]).reshape(t, PEER_HEADS, -1)
    cand_id = (top_i[:, :, 0, :, None] * PEER_NKEYS + top_i[:, :, 1, None, :]).reshape(t, PEER_HEADS, -1)
    best, pos = lax.top_k(cand, PEER_TOPK)
    ids = jnp.take_along_axis(cand_id, pos, axis=-1)
    gate = jax.nn.softmax(best, axis=-1)
    nch = t // PEER_CHUNK

    def chunk(args):
        xc, idc, gc = args
        act = jax.nn.gelu(jnp.einsum('td,thkd->thk', xc, u[idc]).astype(jnp.float32))
        return jnp.einsum('thk,thkd->td', (gc * act).astype(v.dtype), v[idc])

    out = lax.map(chunk, (ht.reshape(nch, PEER_CHUNK, d),
                          ids.reshape(nch, PEER_CHUNK, PEER_HEADS, PEER_TOPK),
                          gate.reshape(nch, PEER_CHUNK, PEER_HEADS, PEER_TOPK)))
    return out.reshape(bsz, s_len, d).astype(h.dtype)


def setup_inputs(seed: int = 0) -> dict:
    key = jax.random.key(seed)
    keys = list(jax.random.split(key, 32))
    f32 = jnp.float32
    ne = (DEPTH + 1) // 2
    no = DEPTH // 2

    def nrm(shape, scale):
        return jax.random.normal(keys.pop(), shape, f32) * scale

    def gain(shape):
        return 1.0 + nrm(shape, 0.02)

    dt = jnp.exp(jax.random.uniform(keys.pop(), (no, C_HEADS), f32, math.log(1e-3), math.log(1e-1)))
    a_init = jax.random.uniform(keys.pop(), (no, C_HEADS), f32, 1.0, 16.0)
    return {
        'x': nrm((BATCH, SEQ, D_MODEL), 1.0),
        'rel_table': nrm((REL_BUCKETS, REL_HEADS), 0.2),
        'ab_w_in': nrm((ne, D_MODEL, AB_IN), D_MODEL ** -0.5),
        'ab_w_out': nrm((ne, AB_MIX, D_MODEL), AB_MIX ** -0.5),
        'ab_lambda': nrm((ne, 4, A_DH), 0.1),
        'ab_a_norm': gain((ne, A_DV)),
        'ab_b_norm': gain((ne, B_DV)),
        'cd_w_in': nrm((no, D_MODEL, CD_IN), D_MODEL ** -0.5),
        'cd_w_out': nrm((no, CD_MIX, D_MODEL), CD_MIX ** -0.5),
        'cd_conv_w': nrm((no, C_CONV, C_CONV_CH), C_CONV ** -0.5),
        'cd_conv_b': nrm((no, C_CONV_CH), 0.02),
        'cd_dt_bias': dt + jnp.log(-jnp.expm1(-dt)),
        'cd_a_log': jnp.log(a_init),
        'cd_d_skip': gain((no, C_HEADS)),
        'cd_ssm_norm': gain((no, C_DINNER)),
        'cd_kv_norm': gain((no, D_LATENT)),
        'cd_w_uk': nrm((no, D_HEADS, D_DH, D_LATENT), D_DH ** -0.5),
        'cd_w_uv': nrm((no, D_HEADS, D_LATENT, D_DH), D_LATENT ** -0.5),
        'norm_mix': gain((DEPTH, D_MODEL)),
        'norm_ffn': gain((DEPTH, D_MODEL)),
        'peer_w_q': nrm((DEPTH, D_MODEL, PEER_HEADS * PEER_DQ), D_MODEL ** -0.5),
        'peer_keys': nrm((DEPTH, PEER_HEADS, 2, PEER_NKEYS, PEER_DQ // 2), (PEER_DQ // 2) ** -0.5),
        'peer_u': nrm((DEPTH, PEER_NEXPERTS, D_MODEL), D_MODEL ** -0.5),
        'peer_v': nrm((DEPTH, PEER_NEXPERTS, D_MODEL), (PEER_HEADS * PEER_TOPK) ** -0.5),
        'norm_final': gain((D_MODEL,)),
    }


def reference(x, rel_table, ab_w_in, ab_w_out, ab_lambda, ab_a_norm, ab_b_norm,
              cd_w_in, cd_w_out, cd_conv_w, cd_conv_b, cd_dt_bias, cd_a_log, cd_d_skip,
              cd_ssm_norm, cd_kv_norm, cd_w_uk, cd_w_uv, norm_mix, norm_ffn,
              peer_w_q, peer_keys, peer_u, peer_v, norm_final):
    h = x
    for layer in range(DEPTH):
        hn = rmsnorm(h, norm_mix[layer])
        i = layer // 2
        if layer % 2 == 0:
            mix = ab_mixer(hn, ab_w_in[i], ab_w_out[i], ab_lambda[i], ab_a_norm[i], ab_b_norm[i],
                           rel_table, layer)
        else:
            mix = cd_mixer(hn, cd_w_in[i], cd_w_out[i], cd_conv_w[i], cd_conv_b[i], cd_dt_bias[i],
                           cd_a_log[i], cd_d_skip[i], cd_ssm_norm[i], cd_kv_norm[i],
                           cd_w_uk[i], cd_w_uv[i], rel_table)
        h = h + mix.astype(h.dtype)
        h = h + peer(rmsnorm(h, norm_ffn[layer]), peer_w_q[layer], peer_keys[layer],
                     peer_u[layer], peer_v[layer])
    return rmsnorm(h, norm_final)
```

```cpp
#include <hip/hip_runtime.h>
#include <hip/hip_cooperative_groups.h>
#include <cstdio>
namespace cg = cooperative_groups;

#define DI __device__ __forceinline__
#define LAS __attribute__((address_space(3)))
typedef unsigned short bf16_t;
typedef short bf16x8 __attribute__((ext_vector_type(8)));
typedef short s16x4 __attribute__((ext_vector_type(4)));
typedef float f32x2 __attribute__((ext_vector_type(2)));
typedef float f32x4 __attribute__((ext_vector_type(4)));
typedef float f32x16 __attribute__((ext_vector_type(16)));
typedef unsigned u32x2 __attribute__((ext_vector_type(2)));
typedef unsigned u32x4 __attribute__((ext_vector_type(4)));
typedef __bf16 bf16v2 __attribute__((ext_vector_type(2)));
typedef float f32x32 __attribute__((ext_vector_type(32)));
typedef _Float16 h16x2 __attribute__((ext_vector_type(2)));
typedef _Float16 h16x32 __attribute__((ext_vector_type(32)));
typedef unsigned u32x6 __attribute__((ext_vector_type(6)));

constexpr int T_TOK = 16384, SEQ = 2048, DM = 2048;
constexpr float EPSN = 1e-6f;
constexpr float LOG2E = 1.4426950408889634f;

DI float bf2f(unsigned short u) { return __uint_as_float((unsigned)u << 16); }
DI float bflo(unsigned u) { return __uint_as_float(u << 16); }
DI float bfhi(unsigned u) { return __uint_as_float(u & 0xffff0000u); }
DI unsigned pk2(float lo, float hi) { f32x2 v = {lo, hi}; bf16v2 b = __builtin_convertvector(v, bf16v2); return __builtin_bit_cast(unsigned, b); }
DI float ex2(float x) { return __builtin_amdgcn_exp2f(x); }
DI float siluf(float v) { return v / (1.0f + __expf(-v)); }
DI f32x16 mfma32(bf16x8 a, bf16x8 b, f32x16 c) { return __builtin_amdgcn_mfma_f32_32x32x16_bf16(a, b, c, 0, 0, 0); }
DI int crow(int i, int h) { return (i & 3) + 8 * (i >> 2) + 4 * h; }
DI f32x16 zero16() { f32x16 z; for (int i = 0; i < 16; ++i) z[i] = 0.f; return z; }
DI int lane_id() { int l; asm volatile("v_mbcnt_lo_u32_b32 %0, -1, 0\n\tv_mbcnt_hi_u32_b32 %0, -1, %0" : "=v"(l)); return l; }
DI int mk_tid(int wv) { return wv * 64 + lane_id(); }
DI float shx(float v, int m, int lane) { return __int_as_float(__builtin_amdgcn_ds_bpermute((lane ^ m) << 2, __float_as_int(v))); }
DI int shxi(int v, int m, int lane) { return __builtin_amdgcn_ds_bpermute((lane ^ m) << 2, v); }
DI void lds_barrier() { asm volatile("s_waitcnt lgkmcnt(0)" ::: "memory"); __builtin_amdgcn_s_barrier(); asm volatile("" ::: "memory"); }
DI float wave_sum(float v, int lane) { for (int o = 32; o > 0; o >>= 1) v += shx(v, o, lane); return v; }

constexpr size_t ws_al(size_t x) { return (x + 255) & ~(size_t)255; }
constexpr size_t OFF_w_ab_in = 0;
constexpr size_t OFF_w_ab_out = OFF_w_ab_in + ws_al(6144ull*2048*2);
constexpr size_t OFF_w_q0 = OFF_w_ab_out + ws_al(2048ull*2048*2);
constexpr size_t OFF_w_q1 = OFF_w_q0 + ws_al(2048ull*2048*2);
constexpr size_t OFF_w_cd_in = OFF_w_q1 + ws_al(2048ull*2048*2);
constexpr size_t OFF_w_cd_out = OFF_w_cd_in + ws_al(7680ull*2048*2);
constexpr size_t OFF_w_kv = OFF_w_cd_out + ws_al(2048ull*3072*2);
constexpr size_t OFF_utab = OFF_w_kv + ws_al(2048ull*256*2);
constexpr int TROW = 1536;
constexpr size_t OFF_vtab = OFF_utab + ws_al(2ull*16384*TROW);
constexpr size_t OFF_usc = OFF_vtab + ws_al(2ull*16384*TROW);
constexpr size_t OFF_vsc = OFF_usc + ws_al(2ull*16384*4);
constexpr size_t OFF_keys = OFF_vsc + ws_al(2ull*16384*4);
constexpr size_t OFF_xb = OFF_keys + ws_al(2ull*8*2*128*128*2);
constexpr size_t OFF_big = OFF_xb + ws_al(16384ull*2048*2);
constexpr size_t OFF_mixed = OFF_big + ws_al(16384ull*7680*2);
constexpr size_t OFF_r1 = OFF_mixed + ws_al(16384ull*3072*2);
constexpr size_t OFF_rope = OFF_r1 + ws_al(16384ull*2048*2);
constexpr size_t OFF_ssq0 = OFF_rope + ws_al(2048ull*32*2*4);
constexpr size_t OFF_ssq2 = OFF_ssq0 + ws_al(16384ull*4);
constexpr size_t OFF_ssqp = OFF_ssq2 + ws_al(16384ull*4);
constexpr size_t OFF_ssqc = OFF_ssqp + ws_al(16384ull*32*4);
constexpr size_t OFF_small = OFF_ssqc + ws_al(16384ull*4*4);
constexpr size_t OFF_r2 = OFF_small + ws_al(16384ull*256*4);
constexpr size_t OFF_btab = OFF_r2 + ws_al(256ull*32*2048*4);
constexpr size_t OFF_mask = OFF_btab + ws_al(8ull*132*4);
constexpr size_t OFF_xc = OFF_mask + ws_al(16384ull*64*4);
constexpr size_t OFF_dtb = OFF_xc + ws_al(16384ull*3072*2);
constexpr size_t OFF_csb = OFF_dtb + ws_al(16384ull*32*4);
constexpr size_t OFF_hbuf = OFF_csb + ws_al(16384ull*32*4);
constexpr size_t OFF_ctr = OFF_hbuf + ws_al(16384ull*2048*4);
constexpr size_t WS_TOTAL = OFF_ctr + ws_al(16384ull);

struct Params {
  const float *x, *rel_table, *ab_w_in, *ab_w_out, *ab_lambda, *ab_a_norm, *ab_b_norm, *cd_w_in, *cd_w_out, *cd_conv_w, *cd_conv_b,
      *cd_dt_bias, *cd_a_log, *cd_d_skip, *cd_ssm_norm, *cd_kv_norm, *cd_w_uk, *cd_w_uv, *norm_mix, *norm_ffn, *peer_w_q, *peer_keys,
      *peer_u, *peer_v, *norm_final;
  float* out;
  unsigned char* ws;
  int wv, pad;
  DI bf16_t* w_ab_in() const { return (bf16_t*)(ws + OFF_w_ab_in); }
  DI bf16_t* w_ab_out() const { return (bf16_t*)(ws + OFF_w_ab_out); }
  DI bf16_t* w_q0() const { return (bf16_t*)(ws + OFF_w_q0); }
  DI bf16_t* w_q1() const { return (bf16_t*)(ws + OFF_w_q1); }
  DI bf16_t* w_cd_in() const { return (bf16_t*)(ws + OFF_w_cd_in); }
  DI bf16_t* w_cd_out() const { return (bf16_t*)(ws + OFF_w_cd_out); }
  DI bf16_t* w_kv() const { return (bf16_t*)(ws + OFF_w_kv); }
  DI unsigned char* utab() const { return ws + OFF_utab; }
  DI unsigned char* vtab() const { return ws + OFF_vtab; }
  DI float* usc() const { return (float*)(ws + OFF_usc); }
  DI float* vsc() const { return (float*)(ws + OFF_vsc); }
  DI bf16_t* keys() const { return (bf16_t*)(ws + OFF_keys); }
  DI bf16_t* xb() const { return (bf16_t*)(ws + OFF_xb); }
  DI bf16_t* big() const { return (bf16_t*)(ws + OFF_big); }
  DI bf16_t* mixed() const { return (bf16_t*)(ws + OFF_mixed); }
  DI bf16_t* r1() const { return (bf16_t*)(ws + OFF_r1); }
  DI float* rope() const { return (float*)(ws + OFF_rope); }
  DI float* ssq0() const { return (float*)(ws + OFF_ssq0); }
  DI float* ssq2() const { return (float*)(ws + OFF_ssq2); }
  DI float* ssqp() const { return (float*)(ws + OFF_ssqp); }
  DI float* ssqc() const { return (float*)(ws + OFF_ssqc); }
  DI float* small() const { return (float*)(ws + OFF_small); }
  DI float* r2() const { return (float*)(ws + OFF_r2); }
  DI float* btab() const { return (float*)(ws + OFF_btab); }
  DI unsigned* mask() const { return (unsigned*)(ws + OFF_mask); }
  DI bf16_t* xc() const { return (bf16_t*)(ws + OFF_xc); }
  DI float* dtb() const { return (float*)(ws + OFF_dtb); }
  DI float* csb() const { return (float*)(ws + OFF_csb); }
  DI float* hbuf() const { return (float*)(ws + OFF_hbuf); }
  DI unsigned* ctr() const { return (unsigned*)(ws + OFF_ctr); }
};

#define XB_TMO      128
#define XB_XCNT(j)  (256  + 64 * (j))
#define XB_XSUB(j)  (1280 + 64 * (j))
#define XB_XGEN(j)  (2304 + 64 * (j))
#define XB_TOP      3328
#define XB_TOPGEN   3392
#define XCD_BAR_WORDS 3456
#define XB_SPIN_CAP (1u << 22)
DI unsigned xb_ld(unsigned* p) { return __hip_atomic_load(p, __ATOMIC_RELAXED, __HIP_MEMORY_SCOPE_AGENT); }
DI unsigned xb_add(unsigned* p, unsigned v) { return __hip_atomic_fetch_add(p, v, __ATOMIC_RELAXED, __HIP_MEMORY_SCOPE_AGENT); }
#define XB_SPIN(cond, bar) do { unsigned _sp = 0; while (cond) { __builtin_amdgcn_s_sleep(1); \
    if ((++_sp & 255u) == 0u) { if (xb_ld(&(bar)[XB_TMO])) break; if (_sp > XB_SPIN_CAP) { atomicAdd(&(bar)[XB_TMO], 1u); break; } } } } while (0)
struct GridBar {
  unsigned* bar; unsigned x; unsigned G; volatile LAS unsigned* st; int wv;
  DI void post() { x = (unsigned)__builtin_amdgcn_s_getreg((3 << 11) | 20) & 0xFu; if (wv == 0 && lane_id() == 0) (void)xb_add(&bar[XB_XCNT(x)], 1u); }
  DI void census(unsigned& nloc, unsigned& nx) const {
    unsigned sum, cnt, mine, sp = 0u;
    for (;;) {
      sum = 0u; cnt = 0u; mine = 0u;
#pragma unroll
      for (unsigned j = 0; j < 16; ++j) { const unsigned c = xb_ld(&bar[XB_XCNT(j)]); sum += c; cnt += (c > 0u) ? 1u : 0u; mine = (j == x) ? c : mine; }
      if (sum == G) break;
      __builtin_amdgcn_s_sleep(1);
      if ((++sp & 255u) == 0u) { if (xb_ld(&bar[XB_TMO])) break; if (sp > XB_SPIN_CAP) { atomicAdd(&bar[XB_TMO], 1u); break; } }
    }
    nloc = mine > 0u ? mine : 1u; nx = cnt > 0u ? cnt : 1u;
  }
  DI void sync() {
    asm volatile("s_waitcnt vmcnt(0)" ::: "memory");
    __syncthreads();
    if (wv == 0 && lane_id() == 0) {
      __builtin_amdgcn_s_waitcnt(0);
      unsigned nloc = st[0], nx = st[1];
      if (nloc == 0u) { census(nloc, nx); st[0] = nloc; st[1] = nx; }
      const unsigned old = xb_add(&bar[XB_XSUB(x)], 1u);
      const unsigned gen = old / nloc;
      if (old + 1u == (gen + 1u) * nloc) {
        __builtin_amdgcn_fence(__ATOMIC_RELEASE, "agent");
        asm volatile("s_waitcnt vmcnt(0)" ::: "memory");
        const unsigned og = xb_add(&bar[XB_TOP], 1u);
        const unsigned tg = og / nx;
        if (og + 1u == (tg + 1u) * nx) xb_add(&bar[XB_TOPGEN], 1u);
        else XB_SPIN(xb_ld(&bar[XB_TOPGEN]) == tg, bar);
        __builtin_amdgcn_fence(__ATOMIC_ACQUIRE, "agent");
        xb_add(&bar[XB_XGEN(x)], 1u);
        asm volatile("s_waitcnt vmcnt(0)" ::: "memory");
      } else {
        XB_SPIN(xb_ld(&bar[XB_XGEN(x)]) == gen, bar);
        __builtin_amdgcn_fence(__ATOMIC_ACQUIRE, "agent");
        asm volatile("s_waitcnt vmcnt(0)" ::: "memory");
      }
    }
    __syncthreads();
  }
};
namespace pg8 {
constexpr int BM = 256, BK = 64, HALF = 128, HTB = HALF * BK * 2, STAGE_BYTES = 8 * HTB, NXCD = 8, WGM = 8;
DI int lds_byte(int r, int c) { const int st = (r >> 4) * 2 + (c >> 5), rr = r & 15, cc = c & 31, ob = rr * 64 + cc * 2; return st * 1024 + (ob ^ (((ob >> 9) & 1) << 5)); }
DI void stage_rc(int b, int& R, int& C) { const int st = b / 1024, sb = b % 1024, swz = sb ^ (((sb >> 9) & 1) << 5); R = (st >> 1) * 16 + swz / 64; C = (st & 1) * 32 + (swz % 64) / 2; }
DI int perm32(int rho) { const int n = rho >> 4, i = rho & 15; return 8 * (i >> 2) + 4 * n + (i & 3); }
struct Unit { int pm, pn; };
struct Gemm { const bf16_t* A; const bf16_t* Bt; int M, N, K, lda; };
struct StaticOrder {
  int nM, nN, nwg, G, c;
  DI void init(int M, int N, int G_, int c_) { nM = M / BM; nN = N / BM; nwg = nM * nN; G = G_; c = c_; }
  DI bool next(int i, Unit& u) const {
    const long L = (long)i * G + c; if (L >= nwg) return false;
    int wgid = (int)L; { const int q = nwg / NXCD, r = nwg % NXCD, xcd = wgid % NXCD, off = wgid / NXCD; wgid = (xcd < r ? xcd * (q + 1) : r * (q + 1) + (xcd - r) * q) + off; }
    const int nig = WGM * nN, gid = wgid / nig, fm = gid * WGM, gsz = (nM - fm) < WGM ? (nM - fm) : WGM;
    u.pm = fm + ((wgid % nig) % gsz); u.pn = (wgid % nig) / gsz; return true;
  }
};

template <class Epi>
DI void gemm_phase(LAS unsigned char* lds, const Gemm g, const StaticOrder& S, const Epi& E, const int wv) {
  const int tid = mk_tid(wv), wid = wv, lane = tid & 63, wr = wid >> 2, wc = wid & 3, fr = lane & 15, fq = lane >> 4;
  const int K = g.K, nt = K / BK, lda = g.lda;
  unsigned voffA[2], voffB[2];
#pragma unroll
  for (int i = 0; i < 2; ++i) { int R, C; stage_rc(tid * 16 + i * 8192, R, C); const int Rb = Epi::PERM ? ((R & ~31) + perm32(R & 31)) : R;
    voffA[i] = (unsigned)(R * lda + C) * 2u; voffB[i] = (unsigned)(Rb * K + C) * 2u; }
  const size_t kstep = (size_t)(BK * 2);
  const size_t hstepA = (size_t)HALF * lda * 2, hstepB = (size_t)HALF * K * 2;
  const size_t tstepA = 2 * hstepA, tstepB = 2 * hstepB;
  const unsigned ldsw = (unsigned)wid * 1024u;
  const int aoff = lds_byte(wr * 64 + fr, fq * 8), boff = lds_byte(wc * 32 + fr, fq * 8);
#define PG8_SA(b, h) (((b) * 2 + (h)) * HTB)
#define PG8_SB(b, h) ((4 + (b) * 2 + (h)) * HTB)
#define PG8_STAGE(bufoff, gbase, voff) do { _Pragma("unroll") for (int _i = 0; _i < 2; ++_i) \
        __builtin_amdgcn_global_load_lds((const unsigned*)((const char*)(gbase) + (voff)[_i]), (LAS unsigned*)(lds + (bufoff) + ldsw + _i * 8192), 16, 0, 0); } while (0)
#define PG8_LDA(dst, b, h) do { _Pragma("unroll") for (int m = 0; m < 4; ++m) _Pragma("unroll") for (int k = 0; k < 2; ++k) dst[m][k] = *(const LAS bf16x8*)(lds + PG8_SA(b, h) + aoff + m * 2048 + k * 1024); } while (0)
#define PG8_LDB(dst, b, h) do { _Pragma("unroll") for (int n = 0; n < 2; ++n) _Pragma("unroll") for (int k = 0; k < 2; ++k) dst[n][k] = *(const LAS bf16x8*)(lds + PG8_SB(b, h) + boff + n * 2048 + k * 1024); } while (0)
#define PG8_MMA(ai, bj, At, Bt) do { __builtin_amdgcn_s_setprio(1); _Pragma("unroll") for (int m = 0; m < 4; ++m) _Pragma("unroll") for (int n = 0; n < 2; ++n) _Pragma("unroll") for (int k = 0; k < 2; ++k) \
        acc[ai][bj][m][n] = __builtin_amdgcn_mfma_f32_16x16x32_bf16(Bt[n][k], At[m][k], acc[ai][bj][m][n], 0, 0, 0); __builtin_amdgcn_s_setprio(0); } while (0)
#define PG8_WAIT_V(n) asm volatile("s_waitcnt vmcnt(" #n ")" ::: "memory")
#define PG8_WAIT_L(n) asm volatile("s_waitcnt lgkmcnt(" #n ")" ::: "memory")
#define PG8_BAR __builtin_amdgcn_s_barrier()
#define PG8_SCHED __builtin_amdgcn_sched_barrier(0)
  Unit cur, nxt; int ui = 0;
  if (!S.next(0, cur)) return;
  f32x4 acc[2][2][4][2];
#pragma unroll
  for (int a = 0; a < 2; ++a)
#pragma unroll
    for (int b = 0; b < 2; ++b)
#pragma unroll
      for (int m = 0; m < 4; ++m)
#pragma unroll
        for (int n = 0; n < 2; ++n) acc[a][b][m][n] = (f32x4){0.f, 0.f, 0.f, 0.f};
  bf16x8 At[4][2], B0[2][2], B1[2][2];
  const char* cA = (const char*)g.A + (size_t)cur.pm * tstepA; const char* cB = (const char*)g.Bt + (size_t)cur.pn * tstepB;
  PG8_STAGE(PG8_SB(0, 0), cB, voffB); PG8_STAGE(PG8_SA(0, 0), cA, voffA); PG8_STAGE(PG8_SB(0, 1), cB + hstepB, voffB); PG8_STAGE(PG8_SA(0, 1), cA + hstepA, voffA);
  if (wr == 1) PG8_BAR;
  PG8_WAIT_V(4); PG8_BAR;
  PG8_STAGE(PG8_SB(1, 0), cB + kstep, voffB); PG8_STAGE(PG8_SA(1, 0), cA + kstep, voffA); PG8_STAGE(PG8_SB(1, 1), cB + hstepB + kstep, voffB);
  PG8_WAIT_V(6); PG8_BAR;
  for (;;) {
    const bool has_next = S.next(ui + 1, nxt);
    const char* nA = has_next ? (const char*)g.A + (size_t)nxt.pm * tstepA : cA; const char* nB = has_next ? (const char*)g.Bt + (size_t)nxt.pn * tstepB : cB;
    for (int t = 0; t < nt; t += 2) {
      const bool last = (t == nt - 2);
      const char* a1 = cA + (size_t)(t + 1) * kstep;
      const char* a2 = last ? nA : cA + (size_t)(t + 2) * kstep; const char* b2 = last ? nB : cB + (size_t)(t + 2) * kstep;
      const char* a3 = a2 + kstep; const char* b3 = b2 + kstep;
      PG8_LDB(B0, 0, 0); PG8_SCHED; PG8_LDA(At, 0, 0); PG8_STAGE(PG8_SA(1, 1), a1 + hstepA, voffA);
      PG8_WAIT_L(8); PG8_BAR; PG8_WAIT_L(0); PG8_MMA(0, 0, At, B0); PG8_BAR; PG8_SCHED;
      PG8_LDB(B1, 0, 1); PG8_STAGE(PG8_SB(0, 0), b2, voffB);
      PG8_BAR; PG8_WAIT_L(0); PG8_MMA(0, 1, At, B1); PG8_BAR;
      PG8_LDA(At, 0, 1); PG8_STAGE(PG8_SA(0, 0), a2, voffA);
      PG8_BAR; PG8_WAIT_L(0); PG8_MMA(1, 0, At, B0); PG8_BAR; PG8_SCHED;
      PG8_STAGE(PG8_SB(0, 1), b2 + hstepB, voffB);
      PG8_WAIT_V(6); PG8_BAR; PG8_MMA(1, 1, At, B1); PG8_BAR;
      PG8_LDB(B0, 1, 0); PG8_SCHED; PG8_LDA(At, 1, 0); PG8_STAGE(PG8_SA(0, 1), a2 + hstepA, voffA);
      PG8_WAIT_L(8); PG8_BAR; PG8_WAIT_L(0); PG8_MMA(0, 0, At, B0); PG8_BAR; PG8_SCHED;
      PG8_LDB(B1, 1, 1); PG8_STAGE(PG8_SB(1, 0), b3, voffB);
      PG8_BAR; PG8_WAIT_L(0); PG8_MMA(0, 1, At, B1); PG8_BAR;
      PG8_LDA(At, 1, 1); PG8_STAGE(PG8_SA(1, 0), a3, voffA);
      PG8_BAR; PG8_WAIT_L(0); PG8_MMA(1, 0, At, B0); PG8_BAR; PG8_SCHED;
      PG8_STAGE(PG8_SB(1, 1), b3 + hstepB, voffB);
      PG8_WAIT_V(6); PG8_BAR; PG8_MMA(1, 1, At, B1); PG8_BAR;
    }
    E(acc, cur, wr, wc, fr, fq);
    if (!has_next) break;
#pragma unroll
    for (int a = 0; a < 2; ++a)
#pragma unroll
      for (int b = 0; b < 2; ++b)
#pragma unroll
        for (int m = 0; m < 4; ++m)
#pragma unroll
          for (int n = 0; n < 2; ++n) acc[a][b][m][n] = (f32x4){0.f, 0.f, 0.f, 0.f};
    cur = nxt; cA = nA; cB = nB; ++ui;
  }
  PG8_WAIT_V(0);
  if (wr == 0) PG8_BAR;
  PG8_BAR;
#undef PG8_SA
#undef PG8_SB
#undef PG8_STAGE
#undef PG8_LDA
#undef PG8_LDB
#undef PG8_MMA
#undef PG8_WAIT_V
#undef PG8_WAIT_L
#undef PG8_BAR
#undef PG8_SCHED
}

#define EPI_PRELOAD_RS(expr) float rs8[8]; _Pragma("unroll") for (int ai = 0; ai < 2; ++ai) _Pragma("unroll") for (int m = 0; m < 4; ++m) { const int row = u.pm * 256 + 128 * ai + 64 * wr + 16 * m + fr; rs8[ai * 4 + m] = (expr); }
#define EPI_ROWS_BEGIN _Pragma("unroll") for (int ai = 0; ai < 2; ++ai) _Pragma("unroll") for (int m = 0; m < 4; ++m) { const int row = u.pm * 256 + 128 * ai + 64 * wr + 16 * m + fr;
#define EPI_COLS_BEGIN _Pragma("unroll") for (int bj = 0; bj < 2; ++bj) { const int col0 = u.pn * 256 + 128 * bj + 32 * wc + 8 * fq; float v[8]; \
      _Pragma("unroll") for (int j = 0; j < 4; ++j) { v[j] = acc[ai][bj][m][0][j]; v[4 + j] = acc[ai][bj][m][1][j]; }
DI void store8bf(bf16_t* p, const float (&v)[8]) { u32x4 w; w.x = pk2(v[0], v[1]); w.y = pk2(v[2], v[3]); w.z = pk2(v[4], v[5]); w.w = pk2(v[6], v[7]); *(u32x4*)p = w; }

struct EpiAbIn {
  static constexpr bool PERM = true;
  bf16_t* O; const float* ssq; const float* rope;
  DI void operator()(const f32x4 (&acc)[2][2][4][2], const Unit& u, int wr, int wc, int fr, int fq) const {
    const int pn = u.pn;
    EPI_PRELOAD_RS(ssq[row])
    EPI_ROWS_BEGIN
      const float rs = rsqrtf(rs8[ai * 4 + m] * (1.0f / 2048.0f) + EPSN); const int pos = row & 2047;
      EPI_COLS_BEGIN
#pragma unroll
        for (int j = 0; j < 8; ++j) v[j] *= rs;
        if (pn < 4) {
#pragma unroll
          for (int j = 0; j < 8; ++j) v[j] *= 0.125f * LOG2E;
        } else if (pn >= 12 && pn < 16) {
          const int f0 = (col0 & 63) >> 1;
          const f32x4 c0 = *(const f32x4*)(rope + (size_t)(pos * 32 + f0) * 2), c1 = *(const f32x4*)(rope + (size_t)(pos * 32 + f0) * 2 + 4);
          const float cs[4] = {c0[0], c0[2], c1[0], c1[2]}, sn[4] = {c0[1], c0[3], c1[1], c1[3]};
          float fac = 0.125f;
          if (pn >= 14) { const int hd = (col0 & 511) >> 6; const float lg = __log2f(1.0f - ex2(-5.0f - (float)hd)); fac = ex2(-(float)(pos & 63) * lg); }
#pragma unroll
          for (int i = 0; i < 4; ++i) { const float a = v[2 * i], b = v[2 * i + 1]; v[2 * i] = (a * cs[i] - b * sn[i]) * fac; v[2 * i + 1] = (a * sn[i] + b * cs[i]) * fac; }
        } else if (pn >= 20) {
#pragma unroll
          for (int j = 0; j < 8; ++j) v[j] = siluf(v[j]);
        }
        store8bf(O + (size_t)row * 6144 + col0, v);
      }
    }
  }
};

template <int NP> DI float row_ssq(const float* part, int row, int fq) {
  float s;
  if (NP == 32) { const f32x4 a = *(const f32x4*)(part + (size_t)row * 32 + fq * 8), b = *(const f32x4*)(part + (size_t)row * 32 + fq * 8 + 4); s = ((a[0] + a[1]) + (a[2] + a[3])) + ((b[0] + b[1]) + (b[2] + b[3])); }
  else s = part[(size_t)row * 4 + fq];
  const int lane = lane_id();
  s += shx(s, 16, lane); s += shx(s, 32, lane);
  return s;
}

struct EpiRes {
  static constexpr bool PERM = true;
  const float* resid; float* out; bf16_t* xb; float* ssq;
  DI void operator()(const f32x4 (&acc)[2][2][4][2], const Unit& u, int wr, int wc, int fr, int fq) const {
#pragma unroll
    for (int ai = 0; ai < 2; ++ai) {
      asm volatile("" ::: "memory");
      f32x4 rr[4][2][2];
#pragma unroll
      for (int m = 0; m < 4; ++m)
#pragma unroll
        for (int bj = 0; bj < 2; ++bj) {
          const size_t off = (size_t)(u.pm * 256 + 128 * ai + 64 * wr + 16 * m + fr) * 2048 + u.pn * 256 + 128 * bj + 32 * wc + 8 * fq;
          rr[m][bj][0] = *(const f32x4*)(resid + off); rr[m][bj][1] = *(const f32x4*)(resid + off + 4);
        }
#pragma unroll
      for (int m = 0; m < 4; ++m) {
        const int row = u.pm * 256 + 128 * ai + 64 * wr + 16 * m + fr;
        float ss = 0.f;
#pragma unroll
        for (int bj = 0; bj < 2; ++bj) {
          const size_t off = (size_t)row * 2048 + u.pn * 256 + 128 * bj + 32 * wc + 8 * fq;
          float v[8];
#pragma unroll
          for (int j = 0; j < 4; ++j) { v[j] = acc[ai][bj][m][0][j] + rr[m][bj][0][j]; v[4 + j] = acc[ai][bj][m][1][j] + rr[m][bj][1][j]; }
#pragma unroll
          for (int j = 0; j < 8; ++j) ss += v[j] * v[j];
          store8bf(xb + off, v);
        }
        ss += shx(ss, 16, fr + 16 * fq); ss += shx(ss, 32, fr + 16 * fq);
        if (fq == 0) ssq[(size_t)row * 32 + u.pn * 4 + wc] = ss;
      }
    }
  }
};

template <int NP> struct EpiScale {
  static constexpr bool PERM = true;
  bf16_t* O; int ldo; const float* ssq; float invn;
  DI void operator()(const f32x4 (&acc)[2][2][4][2], const Unit& u, int wr, int wc, int fr, int fq) const {
    EPI_PRELOAD_RS(row_ssq<NP>(ssq, row, fq))
    EPI_ROWS_BEGIN
      const float rs = rsqrtf(rs8[ai * 4 + m] * invn + EPSN);
      EPI_COLS_BEGIN
#pragma unroll
        for (int j = 0; j < 8; ++j) v[j] *= rs;
        store8bf(O + (size_t)row * ldo + col0, v);
      }
    }
  }
};

struct EpiCdIn {
  static constexpr bool PERM = true;
  bf16_t* O; const float* ssq; float* small; float* ssqc;
  DI void operator()(const f32x4 (&acc)[2][2][4][2], const Unit& u, int wr, int wc, int fr, int fq) const {
    const int pn = u.pn;
    EPI_PRELOAD_RS(ssq[row])
    EPI_ROWS_BEGIN
      const float rs = rsqrtf(rs8[ai * 4 + m] * (1.0f / 2048.0f) + EPSN);
      float ss = 0.f;
      EPI_COLS_BEGIN
#pragma unroll
        for (int j = 0; j < 8; ++j) v[j] *= rs;
        if (pn < 8) {
#pragma unroll
          for (int j = 0; j < 8; ++j) v[j] = siluf(v[j]);
        } else if (pn >= 20 && pn < 24) {
#pragma unroll
          for (int j = 0; j < 8; ++j) v[j] *= 0.08838834764831845f * LOG2E;
        } else if (pn == 28) {
#pragma unroll
          for (int j = 0; j < 8; ++j) ss += v[j] * v[j];
        } else if (pn == 29) {
          float* sp = small + (size_t)row * 256 + (col0 - 7424);
          *(f32x4*)sp = (f32x4){v[0], v[1], v[2], v[3]}; *(f32x4*)(sp + 4) = (f32x4){v[4], v[5], v[6], v[7]};
        }
        store8bf(O + (size_t)row * 7680 + col0, v);
      }
      if (pn == 28) { ss += shx(ss, 16, fr + 16 * fq); ss += shx(ss, 32, fr + 16 * fq); if (fq == 0) ssqc[(size_t)row * 4 + wc] = ss; }
    }
  }
};
}
DI int cd_src_col(int n) {
  if (n < 5120) return n;
  if (n < 6144) return n - 5120 + 5152;
  if (n < 7168) return n - 6144 + 6432;
  if (n < 7424) return n - 7168 + 6176;
  if (n < 7488) return n - 7424 + 7456;
  if (n < 7520) return n - 7488 + 5120;
  if (n < 7536) return n;
  return -1;
}
struct IdMap { DI int operator()(int n) const { return n; } };
struct CdMap { DI int operator()(int n) const { return cd_src_col(n); } };

template <class CM>
DI void prep_wT(LAS float* tile, const float* W, int K, int ldw, bf16_t* dst, int Ndst, const float* gain, CM cm, const int wv, int id0 = -1, int id1 = 0) {
  const int tid = mk_tid(wv), ntk = K / 64, ntn = Ndst / 128;
  const int ib = id0 < 0 ? (int)blockIdx.x : id0, ie = id0 < 0 ? ntk * ntn : id1, is = id0 < 0 ? (int)gridDim.x : 1;
  for (int id = ib; id < ie; id += is) {
    const int k0 = (id % ntk) * 64, n0 = (id / ntk) * 128;
    f32x4 v4[4];
#pragma unroll
    for (int i = 0; i < 4; ++i) {
      const int idx = tid + 512 * i, kk = idx >> 5, c4 = idx & 31, sc = cm(n0 + c4 * 4);
      v4[i] = (f32x4){0.f, 0.f, 0.f, 0.f};
      if (sc >= 0) v4[i] = *(const f32x4*)(W + (size_t)(k0 + kk) * ldw + sc);
      if (gain) v4[i] *= gain[k0 + kk];
    }
#pragma unroll
    for (int i = 0; i < 4; ++i) {
      const int idx = tid + 512 * i, kk = idx >> 5, c4 = idx & 31;
#pragma unroll
      for (int j = 0; j < 4; ++j) tile[kk * 129 + c4 * 4 + j] = v4[i][j];
    }
    __syncthreads();
#pragma unroll
    for (int i = 0; i < 2; ++i) {
      const int idx = tid + 512 * i, nn = idx >> 3, kc = (idx & 7) * 8; float v[8];
#pragma unroll
      for (int j = 0; j < 8; ++j) v[j] = tile[(kc + j) * 129 + nn];
      pg8::store8bf(dst + (size_t)(n0 + nn) * K + k0 + kc, v);
    }
    __syncthreads();
  }
}

DI void cvt_copy(const float* src, bf16_t* dst, size_t n8, const int wv) {
  for (size_t i = (size_t)blockIdx.x * 512 + mk_tid(wv); i < n8; i += (size_t)gridDim.x * 512) {
    const f32x4 a = *(const f32x4*)(src + i * 8), b = *(const f32x4*)(src + i * 8 + 4);
    const float v[8] = {a[0], a[1], a[2], a[3], b[0], b[1], b[2], b[3]};
    pg8::store8bf(dst + i * 8, v);
  }
}

DI void cvt_fp6_rows(const float* src, unsigned char* dst, float* scale, int row0, int row1, const int wv) {
  const int tid = mk_tid(wv), w = tid >> 6, lane = tid & 63;
  for (int row = row0 + w; row < row1; row += 8) {
    float v[32]; float amax = 0.f;
#pragma unroll
    for (int i = 0; i < 4; ++i) {
      const f32x4 a = *(const f32x4*)(src + (size_t)row * 2048 + 512 * i + 8 * lane), b = *(const f32x4*)(src + (size_t)row * 2048 + 512 * i + 8 * lane + 4);
#pragma unroll
      for (int j = 0; j < 4; ++j) { v[8 * i + j] = a[j]; v[8 * i + 4 + j] = b[j]; amax = fmaxf(amax, fmaxf(fabsf(a[j]), fabsf(b[j]))); }
    }
    for (int o = 32; o > 0; o >>= 1) amax = fmaxf(amax, shx(amax, o, lane));
    const unsigned ab = __float_as_uint(amax);
    int e = 0;
    if (amax > 0.f) { const int ex = (int)((ab >> 23) & 255u) - 126; const float mant = __uint_as_float((ab & 0x7fffffu) | 0x3f000000u); e = (mant <= 0.9375f) ? ex - 3 : ex - 2; }
    e = max(e, -126);
    const float inv = __uint_as_float((unsigned)(127 - e) << 23);
    f32x16 lo, hi;
#pragma unroll
    for (int k = 0; k < 16; ++k) { lo[k] = v[k] * inv; hi[k] = v[16 + k] * inv; }
    const u32x6 p = __builtin_amdgcn_cvt_scalef32_2xpk16_fp6_f32(lo, hi, 1.0f);
    *(u32x4*)(dst + (size_t)row * TROW + lane * 16) = (u32x4){p[0], p[1], p[2], p[3]};
    *(u32x2*)(dst + (size_t)row * TROW + 1024 + lane * 8) = (u32x2){p[4], p[5]};
    if (lane == 0) scale[row] = __uint_as_float((unsigned)(e + 127) << 23);
  }
}

__device__ const double kRopeInv[32] = {1.0, 0.7498942093324559, 0.5623413251903491, 0.4216965034285822, 0.31622776601683794, 0.23713737056616552, 0.1778279410038923,
  0.1333521432163324, 0.1, 0.07498942093324558, 0.05623413251903491, 0.042169650342858224, 0.03162277660168379, 0.023713737056616554, 0.01778279410038923, 0.01333521432163324,
  0.01, 0.007498942093324558, 0.005623413251903491, 0.004216965034285823, 0.0031622776601683794, 0.0023713737056616554, 0.0017782794100389228, 0.001333521432163324, 0.001,
  0.0007498942093324559, 0.0005623413251903491, 0.00042169650342858224, 0.00031622776601683794, 0.00023713737056616554, 0.00017782794100389227, 0.0001333521432163324};

DI int rel_bucket_dev(int n) {
  if (n < 16) return n;
  int bkt = 16;
  bkt += (n >= 19) + (n >= 21) + (n >= 24) + (n >= 27) + (n >= 31) + (n >= 35) + (n >= 40) + (n >= 46) + (n >= 52) + (n >= 59) + (n >= 67) + (n >= 77) + (n >= 87) + (n >= 99) + (n >= 113);
  return bkt;
}

constexpr int N_CVT_ITEMS = 264 + 1024;
DI void cvt_item(const Params& P, LAS unsigned char* lds, int it) {
  LAS float* tile = (LAS float*)lds;
  const int wv = P.wv;
  __syncthreads();
  if (it < 32) prep_wT(tile, P.ab_w_out, 2048, 2048, P.w_ab_out(), 2048, nullptr, IdMap(), wv, it * 16, it * 16 + 16);
  else if (it < 64) prep_wT(tile, P.peer_w_q, 2048, 2048, P.w_q0(), 2048, P.norm_ffn, IdMap(), wv, (it - 32) * 16, (it - 32) * 16 + 16);
  else if (it < 96) prep_wT(tile, P.peer_w_q + (size_t)2048 * 2048, 2048, 2048, P.w_q1(), 2048, P.norm_ffn + 2048, IdMap(), wv, (it - 64) * 16, (it - 64) * 16 + 16);
  else if (it < 216) prep_wT(tile, P.cd_w_in, 2048, 7536, P.w_cd_in(), 7680, P.norm_mix + 2048, CdMap(), wv, (it - 96) * 16, (it - 96) * 16 + 16);
  else if (it < 264) prep_wT(tile, P.cd_w_out, 3072, 2048, P.w_cd_out(), 2048, nullptr, IdMap(), wv, (it - 216) * 16, (it - 216) * 16 + 16);
  else {
    const int r = (it - 264) * 64;
    if (r < 32768) cvt_fp6_rows(P.peer_u, P.utab(), P.usc(), r, r + 64, wv);
    else cvt_fp6_rows(P.peer_v, P.vtab(), P.vsc(), r - 32768, r - 32768 + 64, wv);
  }
}

DI void phase_prep(const Params& P, LAS unsigned char* lds) {
  const int wv = P.wv, tid = mk_tid(wv), lane = tid & 63, w = tid >> 6;
  const size_t gtid = (size_t)blockIdx.x * 512 + tid, gsz = (size_t)gridDim.x * 512;
  for (int row0 = (blockIdx.x * 8 + w) * 2; row0 < T_TOK; row0 += gridDim.x * 16) {
    f32x4 ra[2][4][2];
#pragma unroll
    for (int rr = 0; rr < 2; ++rr)
#pragma unroll
      for (int i = 0; i < 4; ++i) { const size_t off = (size_t)(row0 + rr) * 2048 + 512 * i + 8 * lane; ra[rr][i][0] = *(const f32x4*)(P.x + off); ra[rr][i][1] = *(const f32x4*)(P.x + off + 4); }
#pragma unroll
    for (int rr = 0; rr < 2; ++rr) {
      float ss = 0.f;
#pragma unroll
      for (int i = 0; i < 4; ++i) {
        const size_t off = (size_t)(row0 + rr) * 2048 + 512 * i + 8 * lane;
        const f32x4 a = ra[rr][i][0], b = ra[rr][i][1];
        const float v[8] = {a[0], a[1], a[2], a[3], b[0], b[1], b[2], b[3]};
#pragma unroll
        for (int j = 0; j < 8; ++j) ss += v[j] * v[j];
        pg8::store8bf(P.xb() + off, v);
      }
      ss = wave_sum(ss, lane);
      if (lane == 0) P.ssq0()[row0 + rr] = ss;
    }
  }
  LAS float* tile = (LAS float*)lds;
  prep_wT(tile, P.ab_w_in, 2048, 6144, P.w_ab_in(), 6144, P.norm_mix, IdMap(), wv);
  for (size_t i = gtid; i < (size_t)2048 * 256; i += gsz) {
    const int n = (int)(i >> 8), c = (int)(i & 255);
    float v;
    if (n < 1024) v = P.cd_w_uk[(size_t)n * 256 + c];
    else { const int hh = (n - 1024) >> 7, d = (n - 1024) & 127; v = P.cd_w_uv[((size_t)hh * 256 + c) * 128 + d]; }
    v *= P.cd_kv_norm[c];
    P.w_kv()[i] = (bf16_t)(pk2(v, 0.f) & 0xffffu);
  }
  for (size_t i = gtid; i < (size_t)2048 * 32; i += gsz) {
    const int pos = (int)(i >> 5), f = (int)(i & 31);
    const double rev = (double)pos * kRopeInv[f] * 0.15915494309189535;
    const float fr = (float)(rev - floor(rev));
    P.rope()[i * 2] = __builtin_amdgcn_cosf(fr); P.rope()[i * 2 + 1] = __builtin_amdgcn_sinf(fr);
  }
  for (size_t i = gtid; i < (size_t)8 * 132; i += gsz) {
    const int hh = (int)(i / 132), d = (int)(i % 132);
    const int bk = d >= 128 ? 31 : rel_bucket_dev(d);
    P.btab()[i] = P.rel_table[bk * 8 + hh] * LOG2E;
  }
  cvt_copy(P.peer_keys, P.keys(), (size_t)2 * 8 * 2 * 128 * 128 / 8, wv);
}
DI int next_item(unsigned* ctr, LAS int* slot, const int wv) {
  __syncthreads();
  if (wv == 0 && lane_id() == 0) *slot = (int)atomicAdd(ctr, 1u);
  __syncthreads();
  return *slot;
}
DI bf16x8 pack8(const f32x16& x, const int s2) {
  u32x4 p; p.x = pk2(x[8 * s2 + 0], x[8 * s2 + 1]); p.y = pk2(x[8 * s2 + 2], x[8 * s2 + 3]); p.z = pk2(x[8 * s2 + 4], x[8 * s2 + 5]); p.w = pk2(x[8 * s2 + 6], x[8 * s2 + 7]);
  return __builtin_bit_cast(bf16x8, p);
}
DI bf16x8 tr_pair(const LAS unsigned char* p, int hi_off) {
  const s16x4 lo = __builtin_amdgcn_ds_read_tr16_b64_v4i16((LAS s16x4*)p);
  const s16x4 hi = __builtin_amdgcn_ds_read_tr16_b64_v4i16((LAS s16x4*)(p + hi_off));
  return __builtin_shufflevector(lo, hi, 0, 1, 2, 3, 4, 5, 6, 7);
}

template <int DH, int MODE>
DI void attn_core(LAS unsigned char* lds, const bf16_t* Qg, int ldq, const bf16_t* Kg, int ldk, const bf16_t* Vg, int ldv, int q0,
                  const unsigned* maskb, float lg2gamma, const LAS float* btab, f32x16 (&o)[4], float& lsum, const int wv) {
  const int tid = mk_tid(wv), w = tid >> 6, lane = tid & 63, r = lane & 31, h = lane >> 5;
  const int tq = q0 + 32 * w + r;
  constexpr int SUP = (DH == 64) ? 2 : 1, ROWS = 64 * SUP;
  constexpr int KS = DH / 16, KSTR = DH * 2 + 16, KBUF = ROWS * KSTR, VSTR = 320, VBUF = ROWS * VSTR, BUF = KBUF + VBUF;
  constexpr int KCH = DH / 8, NK = (ROWS * KCH) / 512, NV = (ROWS * 16) / 512;
  constexpr bool QLDS = (DH == 128);
  constexpr int QOFF = 80000, QSTRB = DH * 2 + 16;
  bf16x8 bq[QLDS ? 1 : KS];
  if (QLDS) {
#pragma unroll
    for (int s = 0; s < KS; ++s) *(LAS bf16x8*)(lds + QOFF + (32 * w + r) * QSTRB + (16 * s + 8 * h) * 2) = *(const bf16x8*)(Qg + (size_t)tq * ldq + 16 * s + 8 * h);
  } else {
#pragma unroll
    for (int s = 0; s < KS; ++s) bq[QLDS ? 0 : s] = *(const bf16x8*)(Qg + (size_t)tq * ldq + 16 * s + 8 * h);
  }
  const int nkt = (q0 + 256) >> 6, my_last = (q0 + 32 * w + 31) >> 6;
  u32x4 kreg[NK], vreg[NV];
  auto load_tile = [&](int stl) {
#pragma unroll
    for (int i = 0; i < NK; ++i) { const int c = tid + 512 * i, row = c / KCH, ch = c % KCH; kreg[i] = *(const u32x4*)(Kg + (size_t)(stl * ROWS + row) * ldk + ch * 8); }
#pragma unroll
    for (int i = 0; i < NV; ++i) { const int c = tid + 512 * i, row = c >> 4, ch = c & 15; vreg[i] = *(const u32x4*)(Vg + (size_t)(stl * ROWS + row) * ldv + ch * 8); }
  };
  auto write_tile = [&](int b) {
#pragma unroll
    for (int i = 0; i < NK; ++i) { const int c = tid + 512 * i, row = c / KCH, ch = c % KCH; *(LAS u32x4*)(lds + b * BUF + row * KSTR + ch * 16) = kreg[i]; }
#pragma unroll
    for (int i = 0; i < NV; ++i) { const int c = tid + 512 * i, row = c >> 4, ch = c & 15; *(LAS u32x4*)(lds + b * BUF + KBUF + row * VSTR + ch * 16) = vreg[i]; }
  };
  float mrun = -__builtin_inff();
  lsum = 0.f;
#pragma unroll
  for (int d = 0; d < 4; ++d) o[d] = zero16();
  const int vtr = (4 * h + ((lane & 15) >> 2)) * VSTR + (16 * ((lane >> 4) & 1) + 4 * (lane & 3)) * 2;
  __syncthreads();
  load_tile(0); write_tile(0);
  __syncthreads();
  const int nst = nkt / SUP;
  for (int stl = 0; stl < nst; ++stl) {
    if (stl + 1 < nst) load_tile(stl + 1);
#pragma unroll 1
    for (int hf = 0; hf < SUP; ++hf) {
    const int kt = stl * SUP + hf;
    if (kt <= my_last) {
      const LAS unsigned char* kb_base = lds + (stl & 1) * BUF + hf * 64 * KSTR;
      const LAS unsigned char* vb_base = lds + (stl & 1) * BUF + KBUF + hf * 64 * VSTR;
      const int k0 = kt * 64;
      f32x16 st[2];
      __builtin_amdgcn_s_setprio(1);
#pragma unroll
      for (int kb = 0; kb < 2; ++kb) {
        st[kb] = zero16();
#pragma unroll
        for (int s = 0; s < KS; ++s) {
          const bf16x8 kf = *(const LAS bf16x8*)(kb_base + (32 * kb + r) * KSTR + (16 * s + 8 * h) * 2);
          const bf16x8 qf = QLDS ? *(const LAS bf16x8*)(lds + QOFF + (32 * w + r) * QSTRB + (16 * s + 8 * h) * 2) : bq[QLDS ? 0 : s];
          st[kb] = mfma32(kf, qf, st[kb]);
        }
        if (QLDS) __builtin_amdgcn_sched_barrier(0);
      }
      __builtin_amdgcn_s_setprio(0);
      if (MODE == 1) {
        const float a_t = ex2((float)(tq - k0) * lg2gamma);
        const bool diag = (k0 + 63 > q0 + 32 * w);
#pragma unroll
        for (int kb = 0; kb < 2; ++kb)
#pragma unroll
          for (int i = 0; i < 16; ++i) {
            const int key = k0 + 32 * kb + crow(i, h);
            float v = st[kb][i] * a_t;
            if (diag && key > tq) v = 0.f;
            st[kb][i] = v;
          }
      } else {
        const bool near = ((q0 + 32 * w) - (k0 + 63)) < 128;
        unsigned mw[2] = {0xffffffffu, 0xffffffffu};
        if (MODE == 2) { const u32x2 m2 = *(const u32x2*)(maskb + (size_t)tq * 64 + kt * 2); mw[0] = m2.x >> (4 * h); mw[1] = m2.y >> (4 * h); }
        const float ninf = -__builtin_inff();
        if (near) {
#pragma unroll
          for (int kb = 0; kb < 2; ++kb)
#pragma unroll
            for (int i = 0; i < 16; ++i) {
              const int d = tq - (k0 + 32 * kb + crow(i, h));
              const int idx = min(max(d, 0), 128);
              float z = st[kb][i] + btab[idx];
              if (d < 0) z = ninf;
              if (MODE == 2) { if (!((mw[kb] >> ((i & 3) + 8 * (i >> 2))) & 1u)) z = ninf; }
              st[kb][i] = z;
              if (QLDS && i == 15) __builtin_amdgcn_sched_barrier(0);
            }
        } else {
          if (MODE == 2) {
#pragma unroll
            for (int kb = 0; kb < 2; ++kb)
#pragma unroll
              for (int i = 0; i < 16; ++i) if (!((mw[kb] >> ((i & 3) + 8 * (i >> 2))) & 1u)) st[kb][i] = ninf;
          }
        }
        float mx = st[0][0];
#pragma unroll
        for (int kb = 0; kb < 2; ++kb)
#pragma unroll
          for (int i = 0; i < 16; ++i) mx = fmaxf(mx, st[kb][i]);
        mx = fmaxf(mx, shx(mx, 32, lane));
        const float mnew = fmaxf(mrun, mx), msafe = fmaxf(mnew, -1e30f);
        const bool grow = __ballot(mnew > mrun) != 0ull;
        if (grow) {
          const float alpha = ex2(mrun - msafe);
          lsum *= alpha;
#pragma unroll
          for (int d = 0; d < 4; ++d)
#pragma unroll
            for (int i = 0; i < 16; ++i) o[d][i] *= alpha;
        }
        mrun = mnew;
        float rs = 0.f;
#pragma unroll
        for (int kb = 0; kb < 2; ++kb)
#pragma unroll
          for (int i = 0; i < 16; ++i) { const float p = ex2(st[kb][i] - msafe); st[kb][i] = p; rs += p; }
        lsum += rs;
      }
      __builtin_amdgcn_s_setprio(1);
#pragma unroll
      for (int kb = 0; kb < 2; ++kb)
#pragma unroll
        for (int s2 = 0; s2 < 2; ++s2) {
          const bf16x8 pb = pack8(st[kb], s2);
          const LAS unsigned char* vp = vb_base + vtr + (32 * kb + 16 * s2) * VSTR;
#pragma unroll
          for (int d = 0; d < 4; ++d) {
            const bf16x8 vf = tr_pair(vp + d * 64, 8 * VSTR);
            o[d] = mfma32(vf, pb, o[d]);
          }
          if (kb == 0 && s2 == 1) __builtin_amdgcn_sched_barrier(0);
        }
      __builtin_amdgcn_s_setprio(0);
    }
    }
    if (stl + 1 < nst) write_tile((stl + 1) & 1);
    __syncthreads();
  }
}

DI void attn_ab_item(const Params& P, LAS unsigned char* lds, int item, float lam) {
  const int grp = item >> 6, bh = item & 63, b = bh >> 3, hh = bh & 7;
  const int jt[16] = {7, 6, 5, 4, 3, 7, 6, 2, 5, 4, 1, 3, 2, 0, 1, 0};
  const bool isret = ((0xDB60 >> grp) & 1) != 0;
  int j = 0;
#pragma unroll
  for (int g = 0; g < 16; ++g) if (g == grp) j = jt[g];
  const int q0 = j * 256;
  const int tid = mk_tid(P.wv), w = tid >> 6, lane = tid & 63, r = lane & 31, h = lane >> 5;
  const int tq = q0 + 32 * w + r;
  const bf16_t* base = P.big() + (size_t)b * 2048 * 6144;
  LAS float* btab = (LAS float*)(lds + 150016);
  const LAS float* nrm = (const LAS float*)(lds + 151040);
  f32x16 o[4]; float lsum;
  if (!isret) {
    __syncthreads();
    if (tid < 132) btab[tid] = P.btab()[hh * 132 + tid] - P.btab()[hh * 132 + 128];
    float* stash = P.r2() + ((size_t)(blockIdx.x * 8 + w) * 64 + lane) * 64;
#pragma unroll 1
    for (int mp = 0; mp < 2; ++mp) {
      attn_core<64, 0>(lds, base + hh * 128 + 64 * mp, 6144, base + 1024 + hh * 128 + 64 * mp, 6144, base + 2048 + hh * 128, 6144, q0, nullptr, 0.f, btab, o, lsum, P.wv);
      if (mp == 0) {
        const float inv0 = 1.0f / (lsum + shx(lsum, 32, lane));
#pragma unroll
        for (int d = 0; d < 4; ++d)
#pragma unroll
          for (int i = 0; i < 16; ++i) stash[d * 16 + i] = o[d][i] * inv0;
      }
    }
    const float inv = 1.0f / (lsum + shx(lsum, 32, lane));
    float ss = 0.f;
#pragma unroll
    for (int d = 0; d < 4; ++d)
#pragma unroll
      for (int i = 0; i < 16; ++i) { const float v = stash[d * 16 + i] - lam * o[d][i] * inv; o[d][i] = v; ss += v * v; if ((i & 7) == 7) asm volatile("" ::: "memory"); }
    ss += shx(ss, 32, lane);
    const float rstd = rsqrtf(ss * (1.0f / 128.0f) + EPSN) * 0.8f;
    bf16_t* orow = P.mixed() + (size_t)(b * 2048 + tq) * 2048 + hh * 128;
#pragma unroll
    for (int d = 0; d < 4; ++d)
#pragma unroll
      for (int g = 0; g < 4; ++g) {
        const int dv0 = 32 * d + 8 * g + 4 * h;
        const f32x4 an = *(const LAS f32x4*)(nrm + dv0);
        u32x2 wv; wv.x = pk2(o[d][4 * g] * rstd * an[0], o[d][4 * g + 1] * rstd * an[1]); wv.y = pk2(o[d][4 * g + 2] * rstd * an[2], o[d][4 * g + 3] * rstd * an[3]);
        *(u32x2*)(orow + dv0) = wv;
        asm volatile("" ::: "memory");
      }
  } else {
    const float lg = __log2f(1.0f - ex2(-5.0f - (float)hh));
    attn_core<64, 1>(lds, base + 3072 + hh * 64, 6144, base + 3584 + hh * 64, 6144, base + 4096 + hh * 128, 6144, q0, nullptr, lg, btab, o, lsum, P.wv);
    float ss = 0.f;
#pragma unroll
    for (int d = 0; d < 4; ++d)
#pragma unroll
      for (int i = 0; i < 16; ++i) ss += o[d][i] * o[d][i];
    ss += shx(ss, 32, lane);
    const float rstd = rsqrtf(ss * (1.0f / 128.0f) + EPSN);
    const bf16_t* grow = base + (size_t)tq * 6144 + 5120 + hh * 128;
    bf16_t* orow = P.mixed() + (size_t)(b * 2048 + tq) * 2048 + 1024 + hh * 128;
#pragma unroll
    for (int d = 0; d < 4; ++d)
#pragma unroll
      for (int g = 0; g < 4; ++g) {
        const int dv0 = 32 * d + 8 * g + 4 * h;
        const f32x4 bn = *(const LAS f32x4*)(nrm + 128 + dv0);
        const u32x2 gg = *(const u32x2*)(grow + dv0);
        u32x2 wv; wv.x = pk2(o[d][4 * g] * rstd * bn[0] * bflo(gg.x), o[d][4 * g + 1] * rstd * bn[1] * bfhi(gg.x));
        wv.y = pk2(o[d][4 * g + 2] * rstd * bn[2] * bflo(gg.y), o[d][4 * g + 3] * rstd * bn[3] * bfhi(gg.y));
        *(u32x2*)(orow + dv0) = wv;
        asm volatile("" ::: "memory");
      }
  }
}

DI void phase_attn_ab(const Params& P, LAS unsigned char* lds) {
  LAS int* slot = (LAS int*)(lds + 163000);
  float lam;
  { const int lane = lane_id();
    const float a = P.ab_lambda[lane] * P.ab_lambda[64 + lane], b = P.ab_lambda[128 + lane] * P.ab_lambda[192 + lane];
    lam = __expf(wave_sum(a, lane)) - __expf(wave_sum(b, lane)) + 0.2f; }
  { const int t = mk_tid(P.wv); if (t < 256) ((LAS float*)(lds + 151040))[t] = t < 128 ? P.ab_a_norm[t] : P.ab_b_norm[t - 128]; }
  for (;;) {
    const int s = next_item(P.ctr() + 0, slot, P.wv);
    if (s >= 1024 + N_CVT_ITEMS) break;
    if (s < 2048) { if (s & 1) cvt_item(P, lds, s >> 1); else attn_ab_item(P, lds, s >> 1, lam); }
    else cvt_item(P, lds, 1024 + (s - 2048));
  }
}

DI void dsa_attn_item(const Params& P, LAS unsigned char* lds, int item) {
  const int j = 7 - (item >> 6), bh = item & 63, b = bh >> 3, hh = bh & 7, q0 = j * 256;
  const int tid = mk_tid(P.wv), w = tid >> 6, lane = tid & 63, r = lane & 31, h = lane >> 5;
  const int tq = q0 + 32 * w + r;
  LAS float* btab = (LAS float*)(lds + 150016);
  __syncthreads();
  if (tid < 132) btab[tid] = P.btab()[hh * 132 + tid] - P.btab()[hh * 132 + 128];
  f32x16 o[4]; float lsum;
  const bf16_t* qb = P.big() + (size_t)b * 2048 * 7680 + 5120 + hh * 128;
  const bf16_t* kv = P.r1() + (size_t)b * 2048 * 2048;
  attn_core<128, 2>(lds, qb, 7680, kv + hh * 128, 2048, kv + 1024 + hh * 128, 2048, q0, P.mask() + (size_t)b * 2048 * 64, 0.f, btab, o, lsum, P.wv);
  const float inv = 1.0f / (lsum + shx(lsum, 32, lane));
  bf16_t* orow = P.mixed() + (size_t)(b * 2048 + tq) * 3072 + 2048 + hh * 128;
#pragma unroll
  for (int d = 0; d < 4; ++d)
#pragma unroll
    for (int g = 0; g < 4; ++g) {
      const int dv0 = 32 * d + 8 * g + 4 * h;
      u32x2 wv; wv.x = pk2(o[d][4 * g] * inv, o[d][4 * g + 1] * inv); wv.y = pk2(o[d][4 * g + 2] * inv, o[d][4 * g + 3] * inv);
      *(u32x2*)(orow + dv0) = wv;
    }
}
DI unsigned ord_key(float f) { const unsigned b = __float_as_uint(f); return b ^ ((b & 0x80000000u) ? 0xffffffffu : 0x80000000u); }

DI void dsa_index_item(const Params& P, LAS unsigned char* lds, int item) {
  const int qb = 63 - (item >> 3), b = item & 7;
  const int tid = mk_tid(P.wv), w = tid >> 6, lane = tid & 63, r = lane & 31, h = lane >> 5;
  const int tq0 = qb * 32;
  const bf16_t* cd = P.big() + (size_t)b * 2048 * 7680;
  constexpr int QSTR = 2064;
  LAS float* wl = (LAS float*)(lds + 32 * QSTR);
  float* scr = P.r2() + (size_t)blockIdx.x * 32 * 2048;
  __syncthreads();
#pragma unroll
  for (int i = 0; i < 8; ++i) {
    const int c = tid + 512 * i, row = c >> 7, ch = c & 127;
    *(LAS u32x4*)(lds + row * QSTR + ch * 16) = *(const u32x4*)(cd + (size_t)(tq0 + row) * 7680 + 6144 + ch * 8);
  }
  { const int row = tid >> 4, hi = tid & 15; wl[tid] = P.small()[(size_t)(b * 2048 + tq0 + row) * 256 + 96 + hi] * 0.03125f; }
  __syncthreads();
  const int tq = tq0 + r;
#pragma unroll 1
  for (int kt = w; kt <= qb; kt += 8) {
    const int k0 = kt * 32;
    bf16x8 kf[4];
#pragma unroll
    for (int s = 0; s < 4; ++s) kf[s] = *(const bf16x8*)(cd + (size_t)(k0 + r) * 7680 + 7424 + 16 * s + 8 * h);
    f32x16 sc = zero16();
#pragma unroll 2
    for (int hi = 0; hi < 16; ++hi) {
      const float wv_hi = wl[r * 16 + hi];
      f32x16 acc = zero16();
#pragma unroll
      for (int s = 0; s < 4; ++s) {
        const bf16x8 qf = *(const LAS bf16x8*)(lds + r * QSTR + (hi * 64 + 16 * s + 8 * h) * 2);
        acc = mfma32(kf[s], qf, acc);
      }
#pragma unroll
      for (int i = 0; i < 16; ++i) sc[i] += wv_hi * fmaxf(acc[i], 0.f);
    }
#pragma unroll
    for (int g = 0; g < 4; ++g) {
      f32x4 o4;
#pragma unroll
      for (int j = 0; j < 4; ++j) { const int key = k0 + 8 * g + 4 * h + j; o4[j] = key > tq ? -__builtin_inff() : sc[4 * g + j]; }
      *(f32x4*)(scr + (size_t)r * 2048 + k0 + 8 * g + 4 * h) = o4;
    }
  }
  __syncthreads();
  if (tq0 < 256) {
#pragma unroll 1
    for (int rr = 0; rr < 4; ++rr) {
      const int t = tq0 + 4 * w + rr, nvalid = t + 1;
      unsigned long long* mout = (unsigned long long*)(P.mask() + (size_t)(b * 2048 + t) * 64);
#pragma unroll
      for (int i = 0; i < 32; ++i) { const unsigned long long bal = __ballot(64 * i + lane < nvalid); if (lane == 0) mout[i] = bal; }
    }
  } else {
    unsigned u[4][32]; unsigned thr[4]; int cge[4]; bool act[4];
#pragma unroll
    for (int rr = 0; rr < 4; ++rr) {
      const int row = 4 * w + rr, nvalid = tq0 + row + 1;
#pragma unroll
      for (int i = 0; i < 32; ++i) { const int s = 64 * i + lane; const float f = scr[(size_t)row * 2048 + s]; u[rr][i] = (s < nvalid) ? ord_key(f) : 0u; }
      thr[rr] = 0u; cge[rr] = nvalid; act[rr] = true;
    }
#pragma unroll 1
    for (int bit = 31; bit >= 0; --bit) {
      if (!(act[0] || act[1] || act[2] || act[3])) break;
#pragma unroll
      for (int rr = 0; rr < 4; ++rr) {
        const unsigned cand = thr[rr] | (1u << bit);
        int cl = 0;
#pragma unroll
        for (int i = 0; i < 32; ++i) cl += (u[rr][i] >= cand) ? 1 : 0;
        int cnt = 0;
#pragma unroll
        for (int k = 0; k < 6; ++k) cnt += __popcll(__ballot((cl >> k) & 1)) << k;
        const bool take = act[rr] && cnt >= 256;
        thr[rr] = take ? cand : thr[rr]; cge[rr] = take ? cnt : cge[rr]; act[rr] = act[rr] && !(take && cnt == 256);
      }
    }
#pragma unroll
    for (int rr = 0; rr < 4; ++rr) {
      const int t = tq0 + 4 * w + rr, nvalid = t + 1, nslots = (nvalid + 63) >> 6;
      unsigned long long* mout = (unsigned long long*)(P.mask() + (size_t)(b * 2048 + t) * 64);
      const unsigned th = thr[rr];
      if (cge[rr] == 256) {
#pragma unroll
        for (int i = 0; i < 32; ++i) { const unsigned long long bal = __ballot(u[rr][i] >= th && u[rr][i] != 0u); if (lane == 0) mout[i] = (i < nslots) ? bal : 0ull; }
      } else {
        int cgt = 0;
#pragma unroll
        for (int i = 0; i < 32; ++i) cgt += __popcll(__ballot(u[rr][i] > th));
        int need = 256 - cgt;
#pragma unroll
        for (int i = 0; i < 32; ++i) {
          const unsigned long long beq = __ballot(u[rr][i] == th && th != 0u);
          const int rank = __popcll(beq & ((1ull << lane) - 1ull));
          const bool sel = (u[rr][i] > th) || ((u[rr][i] == th) && rank < need);
          const unsigned long long bal = __ballot(sel);
          need -= __popcll(beq); if (need < 0) need = 0;
          if (lane == 0) mout[i] = (i < nslots) ? bal : 0ull;
        }
      }
    }
  }
}

DI unsigned off_b(unsigned row, unsigned ch) { return 256u * row + 16u * (ch ^ (((row & 3) << 2) | ((row >> 2) & 3))); }

DI void ssd_conv_pass(const Params& P) {
  const int tid = mk_tid(P.wv), w = tid >> 6, lane = tid & 63;
  const bf16_t* cd = P.big();
  if (tid < 384) {
    const int col = tid * 8, r0 = blockIdx.x * 64, s0 = r0 & 2047;
    float wgt[4][8], bias[8];
#pragma unroll
    for (int j = 0; j < 4; ++j) { const f32x4 w0 = *(const f32x4*)(P.cd_conv_w + (size_t)j * 3072 + col), w1 = *(const f32x4*)(P.cd_conv_w + (size_t)j * 3072 + col + 4);
#pragma unroll
      for (int e = 0; e < 4; ++e) { wgt[j][e] = w0[e]; wgt[j][4 + e] = w1[e]; } }
    { const f32x4 b0 = *(const f32x4*)(P.cd_conv_b + col), b1 = *(const f32x4*)(P.cd_conv_b + col + 4);
#pragma unroll
      for (int e = 0; e < 4; ++e) { bias[e] = b0[e]; bias[4 + e] = b1[e]; } }
    u32x4 h0 = {0u, 0u, 0u, 0u}, h1 = h0, h2 = h0;
    if (s0 >= 3) { h0 = *(const u32x4*)(cd + (size_t)(r0 - 3) * 7680 + 2048 + col); h1 = *(const u32x4*)(cd + (size_t)(r0 - 2) * 7680 + 2048 + col); h2 = *(const u32x4*)(cd + (size_t)(r0 - 1) * 7680 + 2048 + col); }
#pragma unroll 1
    for (int rb = 0; rb < 64; rb += 8) {
      u32x4 in[8];
#pragma unroll
      for (int k = 0; k < 8; ++k) in[k] = *(const u32x4*)(cd + (size_t)(r0 + rb + k) * 7680 + 2048 + col);
#pragma unroll
      for (int k = 0; k < 8; ++k) {
        const u32x4 x3 = in[k];
        float acc[8];
#pragma unroll
        for (int e = 0; e < 8; ++e) acc[e] = bias[e];
        const u32x4 xs[4] = {h0, h1, h2, x3};
#pragma unroll
        for (int j = 0; j < 4; ++j) {
          acc[0] += wgt[j][0] * bflo(xs[j].x); acc[1] += wgt[j][1] * bfhi(xs[j].x); acc[2] += wgt[j][2] * bflo(xs[j].y); acc[3] += wgt[j][3] * bfhi(xs[j].y);
          acc[4] += wgt[j][4] * bflo(xs[j].z); acc[5] += wgt[j][5] * bfhi(xs[j].z); acc[6] += wgt[j][6] * bflo(xs[j].w); acc[7] += wgt[j][7] * bfhi(xs[j].w);
        }
#pragma unroll
        for (int e = 0; e < 8; ++e) acc[e] = siluf(acc[e]);
        pg8::store8bf(P.xc() + (size_t)(r0 + rb + k) * 3072 + col, acc);
        h0 = h1; h1 = h2; h2 = x3;
      }
    }
  } else {
    for (int k = w - 6; k < 16; k += 2) {
      const int wt = blockIdx.x * 16 + k;
      const int head = wt & 31, bc = wt >> 5, b = bc >> 4, c = bc & 15;
      const float a_h = -__expf(P.cd_a_log[head]), dtbias = P.cd_dt_bias[head];
      const size_t tr = (size_t)b * 2048 + c * 128 + 2 * lane;
      float d0 = P.small()[tr * 256 + 64 + head] + dtbias, d1 = P.small()[(tr + 1) * 256 + 64 + head] + dtbias;
      d0 = d0 > 20.f ? d0 : log1pf(__expf(d0)); d1 = d1 > 20.f ? d1 : log1pf(__expf(d1));
      const float a0 = d0 * a_h, a1 = d1 * a_h;
      float incl = a0 + a1;
#pragma unroll
      for (int o = 1; o < 64; o <<= 1) { const float up = __int_as_float(__builtin_amdgcn_ds_bpermute(((lane - o) & 63) << 2, __float_as_int(incl))); if (lane >= o) incl += up; }
      const size_t o2 = ((size_t)b * 32 + head) * 2048 + c * 128 + 2 * lane;
      *(f32x2*)(P.dtb() + o2) = (f32x2){d0, d1};
      *(f32x2*)(P.csb() + o2) = (f32x2){incl - a1, incl};
    }
  }
}

DI void ssd_item(const Params& P, LAS unsigned char* lds, int item) {
  const int b = item >> 5, head = item & 31, g = head >> 3;
  const int tid = mk_tid(P.wv), w = tid >> 6, lane = tid & 63, r = lane & 31, h = lane >> 5;
  const int lb = w & 3, pb = w >> 2;
  LAS unsigned char* CI = lds;
  LAS unsigned char* BI = lds + 32768;
  LAS unsigned char* XDT = lds + 65536;
  LAS unsigned char* XDW = lds + 90112;
  LAS unsigned char* XR = lds + 114688;
  LAS float* s_dt = (LAS float*)(lds + 139264);
  LAS float* s_cs = s_dt + 128;
  LAS float* s_ecs = s_dt + 256;
  LAS unsigned char* EX = lds + 141312;
  const float dsk = P.cd_d_skip[head];
  const bf16_t* cd = P.big() + (size_t)b * 2048 * 7680;
  const bf16_t* xc = P.xc() + (size_t)b * 2048 * 3072;
  const float* dtp = P.dtb() + ((size_t)b * 32 + head) * 2048;
  const float* csp = P.csb() + ((size_t)b * 32 + head) * 2048;
  f32x16 state = zero16();
  u32x4 rx[2], rb[4], rc[4]; float rdt[2], rcs[2], rlast;
  auto issue = [&](int c) {
    const int t0 = c * 128;
#pragma unroll
    for (int k = 0; k < 2; ++k) { const int row = (tid >> 3) + 64 * k; rx[k] = *(const u32x4*)(xc + (size_t)(t0 + row) * 3072 + head * 64 + (tid & 7) * 8); rdt[k] = dtp[t0 + row]; rcs[k] = csp[t0 + row]; }
#pragma unroll
    for (int k = 0; k < 4; ++k) { const int row = (tid >> 4) + 32 * k; rb[k] = *(const u32x4*)(xc + (size_t)(t0 + row) * 3072 + 2048 + g * 128 + (tid & 15) * 8); rc[k] = *(const u32x4*)(xc + (size_t)(t0 + row) * 3072 + 2560 + g * 128 + (tid & 15) * 8); }
    rlast = csp[t0 + 127];
  };
  __syncthreads();
#pragma unroll
  for (int s2 = 0; s2 < 2; ++s2) *(LAS u32x4*)(EX + (w * 2 + s2) * 1024 + lane * 16) = (u32x4){0u, 0u, 0u, 0u};
  issue(0);
  for (int c = 0; c < 16; ++c) {
    const int t0 = c * 128;
    lds_barrier();
    const float cs_last = rlast;
#pragma unroll
    for (int k = 0; k < 2; ++k) {
      const int row = (tid >> 3) + 64 * k, grp = tid & 7;
      const float dt = rdt[k], dw = dt * __expf(cs_last - rcs[k]);
      const float x[8] = {bflo(rx[k].x), bfhi(rx[k].x), bflo(rx[k].y), bfhi(rx[k].y), bflo(rx[k].z), bfhi(rx[k].z), bflo(rx[k].w), bfhi(rx[k].w)};
      u32x4 bq, cq;
      bq.x = pk2(x[0] * dt, x[1] * dt); bq.y = pk2(x[2] * dt, x[3] * dt); bq.z = pk2(x[4] * dt, x[5] * dt); bq.w = pk2(x[6] * dt, x[7] * dt);
      cq.x = pk2(x[0] * dw, x[1] * dw); cq.y = pk2(x[2] * dw, x[3] * dw); cq.z = pk2(x[4] * dw, x[5] * dw); cq.w = pk2(x[6] * dw, x[7] * dw);
      *(LAS u32x4*)(XR + row * 192 + grp * 16) = rx[k]; *(LAS u32x4*)(XDT + row * 192 + grp * 16) = bq; *(LAS u32x4*)(XDW + row * 192 + grp * 16) = cq;
      if (grp == 0) { s_dt[row] = dt; s_cs[row] = rcs[k]; s_ecs[row] = __expf(rcs[k]); }
    }
#pragma unroll
    for (int k = 0; k < 4; ++k) { const int row = (tid >> 4) + 32 * k; *(LAS u32x4*)(BI + off_b(row, tid & 15)) = rb[k]; *(LAS u32x4*)(CI + off_b(row, tid & 15)) = rc[k]; }
    lds_barrier();
    if (c + 1 < 16) issue(c + 1);
    f32x16 y = zero16();
    const float cs_l = s_cs[32 * lb + r];
    const int xtr = (4 * h + ((lane & 15) >> 2)) * 192 + (32 * pb + 16 * ((lane >> 4) & 1) + 4 * (lane & 3)) * 2;
    for (int sb = 0; sb <= lb; ++sb) {
      f32x16 X = zero16();
#pragma unroll
      for (int ks = 0; ks < 8; ++ks) {
        const bf16x8 af = *(const LAS bf16x8*)(BI + off_b(32 * sb + r, 2 * ks + h));
        const bf16x8 bf = *(const LAS bf16x8*)(CI + off_b(32 * lb + r, 2 * ks + h));
        X = mfma32(af, bf, X);
      }
#pragma unroll
      for (int q = 0; q < 4; ++q) {
        const f32x4 cs4 = *(const LAS f32x4*)(s_cs + 32 * sb + 8 * q + 4 * h);
#pragma unroll
        for (int j = 0; j < 4; ++j) {
          const int s = 32 * sb + 8 * q + 4 * h + j, l = 32 * lb + r;
          const float dec = __expf(cs_l - cs4[j]);
          X[4 * q + j] = (s <= l) ? X[4 * q + j] * dec : 0.f;
        }
      }
#pragma unroll
      for (int s2 = 0; s2 < 2; ++s2) {
        const bf16x8 xa = pack8(X, s2);
        const bf16x8 xb = tr_pair(XDT + xtr + (32 * sb + 16 * s2) * 192, 8 * 192);
        y = mfma32(xa, xb, y);
      }
    }
    {
      f32x16 acc2 = zero16();
#pragma unroll
      for (int nb = 0; nb < 4; ++nb)
#pragma unroll
        for (int s2 = 0; s2 < 2; ++s2) {
          const u32x2 lo = *(const LAS u32x2*)(CI + off_b(32 * lb + r, 4 * nb + 2 * s2) + 8 * h);
          const u32x2 hi = *(const LAS u32x2*)(CI + off_b(32 * lb + r, 4 * nb + 2 * s2 + 1) + 8 * h);
          const u32x4 a4 = {lo.x, lo.y, hi.x, hi.y};
          const bf16x8 sf = *(const LAS bf16x8*)(EX + ((nb + 4 * pb) * 2 + s2) * 1024 + lane * 16);
          acc2 = mfma32(__builtin_bit_cast(bf16x8, a4), sf, acc2);
        }
#pragma unroll
      for (int q = 0; q < 4; ++q) {
        const f32x4 e4 = *(const LAS f32x4*)(s_ecs + 32 * lb + 8 * q + 4 * h);
#pragma unroll
        for (int j = 0; j < 4; ++j) y[4 * q + j] += e4[j] * acc2[4 * q + j];
      }
    }
    {
      const int p = 32 * pb + r;
#pragma unroll
      for (int i = 0; i < 16; ++i) {
        const int l = 32 * lb + crow(i, h);
        const float xv = bf2f(*(const LAS unsigned short*)(XR + l * 192 + p * 2));
        const size_t t = (size_t)(b * 2048 + t0 + l);
        const float v = y[i] + xv * dsk;
        P.mixed()[t * 3072 + head * 64 + p] = (bf16_t)(pk2(v, 0.f) & 0xffffu);
      }
    }
    {
      const float el = __expf(cs_last);
#pragma unroll
      for (int i = 0; i < 16; ++i) state[i] *= el;
      const int q4 = (lane & 15) >> 2, p4 = lane & 3, blk = (lane >> 4) & 1;
      const int xtn = (8 * h + q4) * 192 + (32 * pb + 16 * blk + 4 * p4) * 2;
#pragma unroll
      for (int ks = 0; ks < 8; ++ks) {
        const s16x4 a_lo = __builtin_amdgcn_ds_read_tr16_b64_v4i16((LAS s16x4*)(BI + off_b(16 * ks + 8 * h + q4, 4 * lb + 2 * blk + (p4 >> 1)) + 8 * (p4 & 1)));
        const s16x4 a_hi = __builtin_amdgcn_ds_read_tr16_b64_v4i16((LAS s16x4*)(BI + off_b(16 * ks + 8 * h + 4 + q4, 4 * lb + 2 * blk + (p4 >> 1)) + 8 * (p4 & 1)));
        const bf16x8 af = __builtin_shufflevector(a_lo, a_hi, 0, 1, 2, 3, 4, 5, 6, 7);
        const bf16x8 bf = tr_pair(XDW + xtn + (16 * ks) * 192, 4 * 192);
        state = mfma32(af, bf, state);
      }
    }
    lds_barrier();
#pragma unroll
    for (int s2 = 0; s2 < 2; ++s2) { const bf16x8 sf = pack8(state, s2); *(LAS bf16x8*)(EX + (w * 2 + s2) * 1024 + lane * 16) = sf; }
  }
}

DI void ssd_norm_rows(const Params& P, int row0, int nrows) {
  const int tid = mk_tid(P.wv), w = tid >> 6, lane = tid & 63;
  for (int rr = w; rr < nrows; rr += 8) {
    bf16_t* rowp = P.mixed() + (size_t)(row0 + rr) * 3072;
#pragma unroll
    for (int i = 0; i < 4; ++i) {
      const int c = 512 * i + 8 * lane;
      const u32x4 in = *(const u32x4*)(rowp + c);
      const u32x4 zz = *(const u32x4*)(P.big() + (size_t)(row0 + rr) * 7680 + c);
      float v[8] = {bflo(in.x) * bflo(zz.x), bfhi(in.x) * bfhi(zz.x), bflo(in.y) * bflo(zz.y), bfhi(in.y) * bfhi(zz.y), bflo(in.z) * bflo(zz.z), bfhi(in.z) * bfhi(zz.z), bflo(in.w) * bflo(zz.w), bfhi(in.w) * bfhi(zz.w)};
      float ss = 0.f;
#pragma unroll
      for (int j = 0; j < 8; ++j) ss += v[j] * v[j];
      ss = wave_sum(ss, lane);
      const float rs = rsqrtf(ss * (1.0f / 512.0f) + EPSN);
      const f32x4 g0 = *(const f32x4*)(P.cd_ssm_norm + c), g1 = *(const f32x4*)(P.cd_ssm_norm + c + 4);
#pragma unroll
      for (int j = 0; j < 4; ++j) { v[j] *= rs * g0[j]; v[4 + j] *= rs * g1[j]; }
      pg8::store8bf(rowp + c, v);
    }
  }
}
DI int ord_i(float f) { const int b = __float_as_int(f); return b ^ ((b >> 31) & 0x7fffffff); }
DI float unord_i(int k) { return __int_as_float(k ^ ((k >> 31) & 0x7fffffff)); }
#define MERGE16(A, B) do { _Pragma("unroll") for (int _i = 0; _i < 16; ++_i) A[_i] = max(A[_i], B[15 - _i]); \
    _Pragma("unroll") for (int _d = 8; _d >= 1; _d >>= 1) _Pragma("unroll") for (int _i = 0; _i < 16; ++_i) if ((_i & _d) == 0) { const int _a = A[_i], _b = A[_i + _d]; A[_i] = max(_a, _b); A[_i + _d] = min(_a, _b); } } while (0)
#define INS16(L, xin) do { int _x = (xin); _Pragma("unroll") for (int _i = 0; _i < 16; ++_i) { const int _hi = max(L[_i], _x); _x = min(L[_i], _x); L[_i] = _hi; } } while (0)

#define SORT16(A) do { _Pragma("unroll") for (int _k = 2; _k <= 16; _k <<= 1) _Pragma("unroll") for (int _j = _k >> 1; _j > 0; _j >>= 1) _Pragma("unroll") for (int _i = 0; _i < 16; ++_i) { \
    const int _l = _i ^ _j; if (_l > _i) { const int _a = A[_i], _b = A[_l]; const bool _d = (_i & _k) == 0; A[_i] = _d ? max(_a, _b) : min(_a, _b); A[_l] = _d ? min(_a, _b) : max(_a, _b); } } } while (0)

DI void peer_partA2(const Params& P, LAS unsigned char* lds, int item, int layer) {
  const int tid = mk_tid(P.wv), w = tid >> 6, lane = tid & 63, r = lane & 31, h = lane >> 5;
  LAS unsigned short* EID = (LAS unsigned short*)(lds + 8192);
  LAS float* GATE = (LAS float*)(lds + 24576);
  __syncthreads();
  int L01[2][2][16];
#pragma unroll
  for (int c = 0; c < 2; ++c) {
    bf16x8 bq[2][8];
#pragma unroll
    for (int tl = 0; tl < 2; ++tl) {
      const bf16_t* qp = P.r1() + (size_t)((item + 256 * tl) * 32 + r) * 2048;
#pragma unroll
      for (int s = 0; s < 8; ++s) bq[tl][s] = *(const bf16x8*)(qp + (2 * w + c) * 128 + 16 * s + 8 * h);
    }
    const bf16_t* kbase = P.keys() + ((size_t)((layer * 8 + w) * 2 + c) * 128) * 128;
    int L[2][16];
#pragma unroll
    for (int tl = 0; tl < 2; ++tl)
#pragma unroll
      for (int i = 0; i < 16; ++i) L[tl][i] = (int)0x80000000;
#pragma unroll 1
    for (int kb = 0; kb < 4; ++kb) {
      f32x16 st0 = zero16(), st1 = zero16();
#pragma unroll
      for (int s = 0; s < 8; ++s) {
        const bf16x8 kf = *(const bf16x8*)(kbase + (size_t)(32 * kb + r) * 128 + 16 * s + 8 * h);
        st0 = mfma32(kf, bq[0][s], st0); st1 = mfma32(kf, bq[1][s], st1);
      }
#pragma unroll
      for (int tl = 0; tl < 2; ++tl) {
        int N[16];
#pragma unroll
        for (int i = 0; i < 16; ++i) { const int key = 32 * kb + crow(i, h); N[i] = (ord_i(tl ? st1[i] : st0[i]) & ~127) | (127 - key); }
        SORT16(N);
        MERGE16(L[tl], N);
      }
    }
#pragma unroll
    for (int tl = 0; tl < 2; ++tl) {
      LAS unsigned char* IDX = lds + (tl ? 61696 : 0);
      int M[16];
#pragma unroll
      for (int i = 0; i < 16; ++i) M[i] = shxi(L[tl][i], 32, lane);
#pragma unroll
      for (int i = 0; i < 16; ++i) L[tl][i] = max(L[tl][i], M[15 - i]);
#pragma unroll
      for (int d = 8; d >= 1; d >>= 1)
#pragma unroll
        for (int i = 0; i < 16; ++i) if ((i & d) == 0) { const int a = L[tl][i], bb = L[tl][i + d]; L[tl][i] = max(a, bb); L[tl][i + d] = min(a, bb); }
#pragma unroll
      for (int i = 0; i < 16; ++i) { L01[tl][c][i] = L[tl][i]; IDX[(r * 8 + w) * 32 + c * 16 + i] = (unsigned char)(127 - (L[tl][i] & 127)); }
    }
  }
#pragma unroll
  for (int tl = 0; tl < 2; ++tl) {
    const int tid = mk_tid(P.wv), w = tid >> 6, lane = tid & 63, r = lane & 31, h = lane >> 5;
    LAS unsigned char* IDX = lds + (tl ? 61696 : 0);
    int W[16], C1[16], C2[16], X0 = 0, X1 = 0;
    const float a0 = unord_i(L01[tl][0][0] & ~127);
#pragma unroll
    for (int j = 0; j < 16; ++j) W[j] = (ord_i(a0 + unord_i(L01[tl][1][j] & ~127)) & ~255) | (255 - j);
    {
      int n = 0;
#pragma unroll
      for (int i = 1; i < 16; ++i) {
        const float a = unord_i(L01[tl][0][i] & ~127);
#pragma unroll
        for (int j = 0; j < 16; ++j) if ((i + 1) * (j + 1) <= 16) {
          const float sum = a + unord_i(L01[tl][1][j] & ~127);
          const int key = (ord_i(sum) & ~255) | (255 - (i * 16 + j));
          if (n < 16) C1[n] = key; else if (n < 32) C2[n - 16] = key; else if (n == 32) X0 = key; else X1 = key;
          ++n;
        }
      }
    }
    SORT16(C1); SORT16(C2);
    MERGE16(W, C1); MERGE16(W, C2);
    INS16(W, X0); INS16(W, X1);
    const float v0 = unord_i(W[0] & ~255);
    float e[16], es = 0.f;
#pragma unroll
    for (int k = 0; k < 16; ++k) { e[k] = __expf(unord_i(W[k] & ~255) - v0); es += e[k]; }
    const float inv = 1.0f / es;
#pragma unroll
    for (int k = 0; k < 16; ++k) if ((k >> 3) == h) {
      const int pl = 255 - (W[k] & 255), ci = pl >> 4, cj = pl & 15;
      const int i0 = IDX[(r * 8 + w) * 32 + ci], i1 = IDX[(r * 8 + w) * 32 + 16 + cj];
      EID[(32 * tl + r) * 128 + w * 16 + k] = (unsigned short)(i0 * 128 + i1);
      GATE[(32 * tl + r) * 128 + w * 16 + k] = e[k] * inv;
    }
  }
}

#ifndef PEER_SYNC
#define PEER_SYNC 1
#endif
DI void peer_sort_bands(LAS unsigned char* lds, int wv) {
  const int tid = mk_tid(wv), w = tid >> 6, lane = tid & 63;
  LAS unsigned short* EID = (LAS unsigned short*)(lds + 8192);
  LAS float* GATE = (LAS float*)(lds + 24576);
  const unsigned long long lt = (1ull << lane) - 1ull;
#pragma unroll 1
  for (int it = 0; it < 16; ++it) {
    const int tt = it >> 1, sh = (it & 1) ? 10 : 6;
    const int tok = 32 * (tt >> 2) + 4 * w + (tt & 3);
    const int id0 = EID[tok * 128 + lane], id1 = EID[tok * 128 + 64 + lane];
    const float g0 = GATE[tok * 128 + lane], g1 = GATE[tok * 128 + 64 + lane];
    const int dg0 = (id0 >> sh) & 15, dg1 = (id1 >> sh) & 15;
    int base = 0, p0 = 0, p1 = 0;
#pragma unroll
    for (int bnd = 0; bnd < 16; ++bnd) {
      const unsigned long long b0 = __ballot(dg0 == bnd), b1 = __ballot(dg1 == bnd);
      if (dg0 == bnd) p0 = base + __popcll(b0 & lt);
      if (dg1 == bnd) p1 = base + __popcll(b0) + __popcll(b1 & lt);
      base += __popcll(b0) + __popcll(b1);
    }
    EID[tok * 128 + p0] = (unsigned short)id0; EID[tok * 128 + p1] = (unsigned short)id1;
    GATE[tok * 128 + p0] = g0; GATE[tok * 128 + p1] = g1;
  }
}

#define ISSUE_ROW(TAB, RA, RB, IDS) do { const unsigned _ro = (unsigned)(IDS) * (unsigned)TROW; \
      RA = __builtin_amdgcn_raw_buffer_load_b128(TAB, 16 * lane, _ro, 0); RB = __builtin_amdgcn_raw_buffer_load_b64(TAB, 8 * lane + 1024, _ro, 0); } while (0)
DI void peer_usweep(const Params& P, LAS unsigned char* lds, int layer, int c, GridBar& gb) {
  const int tid = mk_tid(P.wv), w = tid >> 6, lane = tid & 63;
  LAS unsigned short* EID = (LAS unsigned short*)(lds + 8192);
  LAS float* GATE = (LAS float*)(lds + 24576);
  const __amdgpu_buffer_rsrc_t utab = __builtin_amdgcn_make_buffer_rsrc((void*)(P.utab() + (size_t)layer * 16384 * TROW), 0, 0x7fffffff, 0x00020000);
  const __amdgpu_buffer_rsrc_t vtab = __builtin_amdgcn_make_buffer_rsrc((void*)(P.vtab() + (size_t)layer * 16384 * TROW), 0, 0x7fffffff, 0x00020000);
  const float* usc = P.usc() + layer * 16384;
  const float* vsc = P.vsc() + layer * 16384;
  const float* gffn = P.norm_ffn + layer * 2048;
  const int qsel = ((lane >> 5) & 1) + 2 * ((lane >> 4) & 1);
  {
    h16x2 xq[8][16];
    const int lx = lane_id();
#pragma unroll
    for (int tt = 0; tt < 8; ++tt) {
      const size_t t = (size_t)(c + 256 * (tt >> 2)) * 32 + 4 * w + (tt & 3);
      const float rs = rsqrtf(wave_sum(lane < 32 ? P.ssqp()[t * 32 + lane] : 0.f, lane) * (1.0f / 2048.0f) + EPSN);
#pragma unroll
      for (int i = 0; i < 4; ++i) {
        const int cc = 512 * i + 8 * lx;
        const u32x4 hb = *(const u32x4*)(P.xb() + t * 2048 + cc);
        const f32x4 a = {__uint_as_float(hb.x << 16), __uint_as_float(hb.x & 0xffff0000u), __uint_as_float(hb.y << 16), __uint_as_float(hb.y & 0xffff0000u)};
        const f32x4 b = {__uint_as_float(hb.z << 16), __uint_as_float(hb.z & 0xffff0000u), __uint_as_float(hb.w << 16), __uint_as_float(hb.w & 0xffff0000u)};
        const f32x4 g0 = *(const f32x4*)(gffn + cc), g1 = *(const f32x4*)(gffn + cc + 4);
#pragma unroll
        for (int j = 0; j < 4; ++j) {
          const _Float16 v0 = (_Float16)(a[j] * rs * g0[j]), v1 = (_Float16)(b[j] * rs * g1[j]);
          if (i < 2) { xq[tt][8 * i + j].x = v0; xq[tt][8 * i + 4 + j].x = v1; } else { xq[tt][8 * i + j - 16].y = v0; xq[tt][8 * i + 4 + j - 16].y = v1; }
        }
      }
    }
    gb.sync();
    u32x4 ua[2][4]; u32x2 ub[2][4]; float usf[2], vsf[2];
#pragma unroll
    for (int st = 0; st < 2; ++st) { const int eb0 = (4 * w + st) * 128;
      const int idq = (int)EID[eb0 + qsel]; usf[st] = usc[idq]; vsf[st] = vsc[idq];
#pragma unroll
      for (int q = 0; q < 4; ++q) ISSUE_ROW(utab, ua[st][q], ub[st][q], __builtin_amdgcn_readfirstlane((int)EID[eb0 + q])); }
    float dp0 = 0.f, dp1 = 0.f, dp2 = 0.f, dp3 = 0.f, usf_p = 0.f, vsf_p = 0.f; int ebp = -1;
    const bool h32 = (lane & 32) != 0, h16 = (lane & 16) != 0;
#pragma unroll 1
    for (int j = 0; j < 32; ++j) {
#pragma unroll
      for (int tt = 0; tt < 8; ++tt) {
        {
          const int eb = (32 * (tt >> 2) + 4 * w + (tt & 3)) * 128 + 4 * j;
          const int st = tt & 1;
          const int ebn = (tt < 6) ? (32 * ((tt + 2) >> 2) + 4 * w + ((tt + 2) & 3)) * 128 + 4 * j : (4 * w + tt - 6) * 128 + 4 * min(j + 1, 31);
          const u32x2 idn = *(const LAS u32x2*)(EID + ebn);
          const int idq = (int)EID[ebn + qsel];
          const float gprev = GATE[max(ebp, 0) + qsel];
          const float usf_c = usf[st], vsf_c = vsf[st];
          usf[st] = usc[idq]; vsf[st] = vsc[idq];
          float d4[4];
          float r0 = 0.f, r1 = 0.f, rd = 0.f, c8 = 0.f;
#pragma unroll
          for (int q = 0; q < 4; ++q) {
            if (q == 0) { r0 = shx(h32 ? dp0 : dp1, 32, lane); r1 = shx(h32 ? dp2 : dp3, 32, lane); }
            if (q == 1) { r0 += h32 ? dp1 : dp0; r1 += h32 ? dp3 : dp2; c8 = shx(h16 ? r0 : r1, 16, lane); }
            if (q == 2) { rd = (h16 ? r1 : r0) + c8; c8 = shx(rd, 8, lane); }
            if (q == 3) { rd += c8; c8 = shx(rd, 4, lane); }
            __builtin_amdgcn_sched_barrier(0);
            float da = 0.f, db = 0.f;
            const u32x6 pk = {ua[st][q].x, ua[st][q].y, ua[st][q].z, ua[st][q].w, ub[st][q].x, ub[st][q].y};
            const h16x32 f = __builtin_amdgcn_cvt_scalef32_pk32_f16_fp6(pk, 1.0f);
#pragma unroll
            for (int m = 0; m < 16; m += 2) {
              da = __builtin_amdgcn_fdot2((h16x2){f[2 * m], f[2 * m + 1]}, xq[tt][m], da, false);
              db = __builtin_amdgcn_fdot2((h16x2){f[2 * m + 2], f[2 * m + 3]}, xq[tt][m + 1], db, false);
            }
            float dq = da + db;
            { const int s2 = __builtin_amdgcn_readfirstlane((int)(q < 2 ? idn.x : idn.y));
              unsigned ro = (unsigned)((q & 1) ? (int)((unsigned)s2 >> 16) : (s2 & 0xffff)) * (unsigned)TROW;
              asm volatile("" : "+v"(dq), "+s"(ro));
              ua[st][q] = __builtin_amdgcn_raw_buffer_load_b128(utab, 16 * lane, ro, 0); ub[st][q] = __builtin_amdgcn_raw_buffer_load_b64(utab, 8 * lane + 1024, ro, 0); }
            d4[q] = dq;
            __builtin_amdgcn_sched_barrier(0);
          }
          {
            float d = rd + c8; d += shx(d, 2, lane); d += shx(d, 1, lane);
            d *= usf_p;
            const float u3 = 0.7978845608028654f * (d + 0.044715f * d * d * d);
            const float th = 1.0f - 2.0f * __builtin_amdgcn_rcpf(__expf(2.0f * u3) + 1.0f);
            const float act = 0.5f * d * (1.0f + th);
            if ((lane & 15) == 0 && ebp >= 0) GATE[ebp + qsel] = gprev * act * vsf_p;
          }
          dp0 = d4[0]; dp1 = d4[1]; dp2 = d4[2]; dp3 = d4[3]; usf_p = usf_c; vsf_p = vsf_c; ebp = eb;
        }
      }
    }
    {
      float k0 = h32 ? dp1 : dp0; k0 += shx(h32 ? dp0 : dp1, 32, lane);
      float k1 = h32 ? dp3 : dp2; k1 += shx(h32 ? dp2 : dp3, 32, lane);
      float d = h16 ? k1 : k0; d += shx(h16 ? k0 : k1, 16, lane);
      d += shx(d, 8, lane); d += shx(d, 4, lane); d += shx(d, 2, lane); d += shx(d, 1, lane);
      d *= usf_p;
      const float u3 = 0.7978845608028654f * (d + 0.044715f * d * d * d);
      const float th = 1.0f - 2.0f * __builtin_amdgcn_rcpf(__expf(2.0f * u3) + 1.0f);
      const float act = 0.5f * d * (1.0f + th);
      if ((lane & 15) == 0) GATE[ebp + qsel] *= act * vsf_p;
    }
  }
}

DI void peer_vsweep(const Params& P, LAS unsigned char* lds, int layer, int sidx, int c, GridBar& gb) {
  const int tid = mk_tid(P.wv), w = tid >> 6, lane = tid & 63;
  const int rb = 32 * sidx + 4 * w;
  const size_t tg = (size_t)(c + 256 * sidx) * 32 + 4 * w;
  LAS unsigned short* EID = (LAS unsigned short*)(lds + 8192);
  LAS float* GATE = (LAS float*)(lds + 24576);
  const __amdgpu_buffer_rsrc_t utab = __builtin_amdgcn_make_buffer_rsrc((void*)(P.utab() + (size_t)layer * 16384 * TROW), 0, 0x7fffffff, 0x00020000);
  const __amdgpu_buffer_rsrc_t vtab = __builtin_amdgcn_make_buffer_rsrc((void*)(P.vtab() + (size_t)layer * 16384 * TROW), 0, 0x7fffffff, 0x00020000);
  const float* usc = P.usc() + layer * 16384;
  const float* vsc = P.vsc() + layer * 16384;
  const float* gffn = P.norm_ffn + layer * 2048;
  const int qsel = ((lane >> 5) & 1) + 2 * ((lane >> 4) & 1);
  {
    f32x2 ac[4][16];
#pragma unroll
    for (int tt = 0; tt < 4; ++tt)
#pragma unroll
      for (int i = 0; i < 16; ++i) ac[tt][i] = (f32x2){0.f, 0.f};
    if (PEER_SYNC) gb.sync();
    u32x4 va[4]; u32x2 vb[4];
    f32x4 wcur;
    { const int eb0 = rb * 128;
      wcur = *(const LAS f32x4*)(GATE + eb0);
#pragma unroll
      for (int q = 0; q < 4; ++q) ISSUE_ROW(vtab, va[q], vb[q], __builtin_amdgcn_readfirstlane((int)EID[eb0 + q])); }
#pragma unroll 1
    for (int j = 0; j < 32; ++j) {
#pragma unroll
      for (int tt = 0; tt < 4; ++tt) {
        {
          const int ebn = (tt < 3) ? (rb + tt + 1) * 128 + 4 * j : rb * 128 + 4 * min(j + 1, 31);
          const u32x2 idn = *(const LAS u32x2*)(EID + ebn);
          const f32x4 wnext = *(const LAS f32x4*)(GATE + ebn);
#pragma unroll
          for (int q = 0; q < 4; ++q) {
            const float wq = wcur[q];
            const u32x6 pk = {va[q].x, va[q].y, va[q].z, va[q].w, vb[q].x, vb[q].y};
            const f32x32 f = __builtin_amdgcn_cvt_scalef32_pk32_f32_fp6(pk, 1.0f);
            { const int s2 = __builtin_amdgcn_readfirstlane((int)(q < 2 ? idn.x : idn.y));
              ISSUE_ROW(vtab, va[q], vb[q], (q & 1) ? (int)((unsigned)s2 >> 16) : (s2 & 0xffff)); }
#pragma unroll
            for (int m = 0; m < 16; ++m) ac[tt][m] = __builtin_elementwise_fma((f32x2){f[2 * m], f[2 * m + 1]}, (f32x2){wq, wq}, ac[tt][m]);
            asm volatile("" : "+v"(ac[tt][0]), "+v"(ac[tt][1]), "+v"(ac[tt][2]), "+v"(ac[tt][3]), "+v"(ac[tt][4]), "+v"(ac[tt][5]), "+v"(ac[tt][6]), "+v"(ac[tt][7]));
            asm volatile("" : "+v"(ac[tt][8]), "+v"(ac[tt][9]), "+v"(ac[tt][10]), "+v"(ac[tt][11]), "+v"(ac[tt][12]), "+v"(ac[tt][13]), "+v"(ac[tt][14]), "+v"(ac[tt][15]));
            __builtin_amdgcn_sched_barrier(0);
          }
          wcur = wnext;
        }
      }
    }
#undef ISSUE_ROW
#pragma unroll
    for (int tt = 0; tt < 4; ++tt) {
      const size_t t = tg + tt;
      const int lane = lane_id();
      float acc[32];
#pragma unroll
      for (int n = 0; n < 16; ++n) { acc[n] = ac[tt][n].x; acc[16 + n] = ac[tt][n].y; }
      float ss = 0.f;
#pragma unroll
      for (int i = 0; i < 4; ++i) {
        const int cc = 512 * i + 8 * lane;
        const u32x4 hb = *(const u32x4*)(P.xb() + t * 2048 + cc);
        const f32x4 a = {__uint_as_float(hb.x << 16), __uint_as_float(hb.x & 0xffff0000u), __uint_as_float(hb.y << 16), __uint_as_float(hb.y & 0xffff0000u)};
        const f32x4 b = {__uint_as_float(hb.z << 16), __uint_as_float(hb.z & 0xffff0000u), __uint_as_float(hb.w << 16), __uint_as_float(hb.w & 0xffff0000u)};
#pragma unroll
        for (int j = 0; j < 4; ++j) { acc[8 * i + j] += a[j]; acc[8 * i + 4 + j] += b[j]; }
#pragma unroll
        for (int j = 0; j < 8; ++j) ss += acc[8 * i + j] * acc[8 * i + j];
      }
      ss = wave_sum(ss, lane);
      if (layer == 0) {
#pragma unroll
        for (int i = 0; i < 4; ++i) {
          const int cc = 512 * i + 8 * lane;
          *(f32x4*)(P.hbuf() + t * 2048 + cc) = (f32x4){acc[8 * i], acc[8 * i + 1], acc[8 * i + 2], acc[8 * i + 3]};
          *(f32x4*)(P.hbuf() + t * 2048 + cc + 4) = (f32x4){acc[8 * i + 4], acc[8 * i + 5], acc[8 * i + 6], acc[8 * i + 7]};
          const float v[8] = {acc[8 * i], acc[8 * i + 1], acc[8 * i + 2], acc[8 * i + 3], acc[8 * i + 4], acc[8 * i + 5], acc[8 * i + 6], acc[8 * i + 7]};
          pg8::store8bf(P.xb() + t * 2048 + cc, v);
        }
        if (lane == 0) P.ssq2()[t] = ss;
      } else {
        const float rf = rsqrtf(ss * (1.0f / 2048.0f) + EPSN);
#pragma unroll
        for (int i = 0; i < 4; ++i) {
          const int cc = 512 * i + 8 * lane;
          const f32x4 g0 = *(const f32x4*)(P.norm_final + cc), g1 = *(const f32x4*)(P.norm_final + cc + 4);
          *(f32x4*)(P.out + t * 2048 + cc) = (f32x4){acc[8 * i] * rf * g0[0], acc[8 * i + 1] * rf * g0[1], acc[8 * i + 2] * rf * g0[2], acc[8 * i + 3] * rf * g0[3]};
          *(f32x4*)(P.out + t * 2048 + cc + 4) = (f32x4){acc[8 * i + 4] * rf * g1[0], acc[8 * i + 5] * rf * g1[1], acc[8 * i + 6] * rf * g1[2], acc[8 * i + 7] * rf * g1[3]};
        }
      }
    }
  }
}

DI void peer_phase(const Params& P, LAS unsigned char* lds, int layer, int c, GridBar& gb) {
  peer_partA2(P, lds, c, layer);
  __syncthreads();
  peer_sort_bands(lds, P.wv);
  peer_usweep(P, lds, layer, c, gb);
  peer_vsweep(P, lds, layer, 0, c, gb);
  peer_vsweep(P, lds, layer, 1, c, gb);
}
#define GBAR() gbar.sync()
__global__ void __launch_bounds__(512) hybrid_forward(Params Pk) {
  extern __shared__ __attribute__((aligned(16))) unsigned char lds_raw[];
  LAS unsigned char* lds = (LAS unsigned char*)lds_raw;
  cg::grid_group grid = cg::this_grid();
  Params P = Pk; P.wv = __builtin_amdgcn_readfirstlane((int)(threadIdx.x >> 6));
  LAS int* slot = (LAS int*)(lds + 163000);
  pg8::StaticOrder so;
  const int G = gridDim.x, c = blockIdx.x;

  GridBar gbar{P.ctr(), 0u, (unsigned)G, (volatile LAS unsigned*)(lds + 163008), P.wv};
  if (threadIdx.x < 2) gbar.st[threadIdx.x] = 0u;
  __syncthreads();
  gbar.post();
  phase_prep(P, lds);
  grid.sync();
  { so.init(T_TOK, 6144, G, c); pg8::Gemm g{P.xb(), P.w_ab_in(), T_TOK, 6144, 2048, 2048};
    pg8::EpiAbIn e{P.big(), P.ssq0(), P.rope()}; pg8::gemm_phase(lds, g, so, e, P.wv); }
  GBAR();
  phase_attn_ab(P, lds);
  GBAR();
  { so.init(T_TOK, 2048, G, c); pg8::Gemm g{P.mixed(), P.w_ab_out(), T_TOK, 2048, 2048, 2048};
    pg8::EpiRes e{P.x, P.hbuf(), P.xb(), P.ssqp()}; pg8::gemm_phase(lds, g, so, e, P.wv); }
  GBAR();
  { so.init(T_TOK, 2048, G, c); pg8::Gemm g{P.xb(), P.w_q0(), T_TOK, 2048, 2048, 2048};
    pg8::EpiScale<32> e{P.r1(), 2048, P.ssqp(), 1.0f / 2048.0f}; pg8::gemm_phase(lds, g, so, e, P.wv); }
  GBAR();
  peer_phase(P, lds, 0, c, gbar);
  GBAR();
  { so.init(T_TOK, 7680, G, c); pg8::Gemm g{P.xb(), P.w_cd_in(), T_TOK, 7680, 2048, 2048};
    pg8::EpiCdIn e{P.big(), P.ssq2(), P.small(), P.ssqc()}; pg8::gemm_phase(lds, g, so, e, P.wv); }
  GBAR();
  { so.init(T_TOK, 2048, G, c); pg8::Gemm g{P.big() + 7168, P.w_kv(), T_TOK, 2048, 256, 7680};
    pg8::EpiScale<4> e{P.r1(), 2048, P.ssqc(), 1.0f / 256.0f}; pg8::gemm_phase(lds, g, so, e, P.wv); }
  ssd_conv_pass(P);
  for (;;) {
    const int item = next_item(P.ctr() + 1, slot, P.wv);
    if (item >= 512) break;
    dsa_index_item(P, lds, item);
  }
  GBAR();
  ssd_item(P, lds, c);
  dsa_attn_item(P, lds, c); dsa_attn_item(P, lds, 511 - c);
  GBAR();
  ssd_norm_rows(P, c * 64, 64);
  GBAR();
  { so.init(T_TOK, 2048, G, c); pg8::Gemm g{P.mixed(), P.w_cd_out(), T_TOK, 2048, 3072, 3072};
    pg8::EpiRes e{P.hbuf(), P.hbuf(), P.xb(), P.ssqp()}; pg8::gemm_phase(lds, g, so, e, P.wv); }
  GBAR();
  { so.init(T_TOK, 2048, G, c); pg8::Gemm g{P.xb(), P.w_q1(), T_TOK, 2048, 2048, 2048};
    pg8::EpiScale<32> e{P.r1(), 2048, P.ssqp(), 1.0f / 2048.0f}; pg8::gemm_phase(lds, g, so, e, P.wv); }
  GBAR();
  peer_phase(P, lds, 1, c, gbar);
}

extern "C" void kernel_launch(void* const* d_in, const int* in_sizes, int n_in, void* d_out, int out_size, void* d_ws, size_t ws_size, hipStream_t stream) {
  constexpr size_t kDynLds = 160 * 1024;
  static int grid_blocks = 0;
  if (!grid_blocks) {
    (void)hipFuncSetAttribute((const void*)hybrid_forward, hipFuncAttributeMaxDynamicSharedMemorySize, (int)kDynLds);
    int dev = 0, cus = 0, per_cu = 0;
    (void)hipGetDevice(&dev);
    (void)hipDeviceGetAttribute(&cus, hipDeviceAttributeMultiprocessorCount, dev);
    (void)hipOccupancyMaxActiveBlocksPerMultiprocessor(&per_cu, hybrid_forward, 512, kDynLds);
    if (per_cu < 1) fprintf(stderr, "occupancy query returned %d\n", per_cu);
    if (cus < 256) fprintf(stderr, "need 256 CUs, found %d\n", cus);
    grid_blocks = 256;
  }
  Params p{};
  const float* const* in = (const float* const*)d_in;
  p.x = in[0]; p.rel_table = in[1]; p.ab_w_in = in[2]; p.ab_w_out = in[3]; p.ab_lambda = in[4]; p.ab_a_norm = in[5]; p.ab_b_norm = in[6];
  p.cd_w_in = in[7]; p.cd_w_out = in[8]; p.cd_conv_w = in[9]; p.cd_conv_b = in[10]; p.cd_dt_bias = in[11]; p.cd_a_log = in[12]; p.cd_d_skip = in[13];
  p.cd_ssm_norm = in[14]; p.cd_kv_norm = in[15]; p.cd_w_uk = in[16]; p.cd_w_uv = in[17]; p.norm_mix = in[18]; p.norm_ffn = in[19];
  p.peer_w_q = in[20]; p.peer_keys = in[21]; p.peer_u = in[22]; p.peer_v = in[23]; p.norm_final = in[24];
  p.out = (float*)d_out;
  p.ws = (unsigned char*)d_ws; p.wv = 0; p.pad = 0;
  if (WS_TOTAL > ws_size) { fprintf(stderr, "workspace too small: need %zu have %zu\n", (size_t)WS_TOTAL, ws_size); return; }
  (void)hipMemsetAsync(p.ws + OFF_ctr, 0, 16384, stream);
  void* args[] = {&p};
  hipError_t e = hipLaunchCooperativeKernel((void*)hybrid_forward, dim3(grid_blocks), dim3(512), args, kDynLds, stream);
  if (e != hipSuccess) fprintf(stderr, "cooperative launch failed: %s (grid %d)\n", hipGetErrorString(e), grid_blocks);
}
```

```cpp
#include <hip/hip_runtime.h>
#include <hip/hip_cooperative_groups.h>
#include <cstdio>
namespace cg = cooperative_groups;

#define DI __device__ __forceinline__
#define LAS __attribute__((address_space(3)))
typedef unsigned short bf16_t;
typedef short bf16x8 __attribute__((ext_vector_type(8)));
typedef short s16x4 __attribute__((ext_vector_type(4)));
typedef float f32x2 __attribute__((ext_vector_type(2)));
typedef float f32x4 __attribute__((ext_vector_type(4)));
typedef float f32x16 __attribute__((ext_vector_type(16)));
typedef unsigned u32x2 __attribute__((ext_vector_type(2)));
typedef unsigned u32x4 __attribute__((ext_vector_type(4)));
typedef __bf16 bf16v2 __attribute__((ext_vector_type(2)));
typedef float f32x32 __attribute__((ext_vector_type(32)));
typedef _Float16 h16x2 __attribute__((ext_vector_type(2)));
typedef _Float16 h16x32 __attribute__((ext_vector_type(32)));
typedef unsigned u32x6 __attribute__((ext_vector_type(6)));

constexpr int T_TOK = 16384, SEQ = 2048, DM = 2048;
constexpr float EPSN = 1e-6f;
constexpr float LOG2E = 1.4426950408889634f;

DI float bf2f(unsigned short u) { return __uint_as_float((unsigned)u << 16); }
DI float bflo(unsigned u) { return __uint_as_float(u << 16); }
DI float bfhi(unsigned u) { return __uint_as_float(u & 0xffff0000u); }
DI unsigned pk2(float lo, float hi) { f32x2 v = {lo, hi}; bf16v2 b = __builtin_convertvector(v, bf16v2); return __builtin_bit_cast(unsigned, b); }
DI float ex2(float x) { return __builtin_amdgcn_exp2f(x); }
DI float siluf(float v) { return v / (1.0f + __expf(-v)); }
DI f32x16 mfma32(bf16x8 a, bf16x8 b, f32x16 c) { return __builtin_amdgcn_mfma_f32_32x32x16_bf16(a, b, c, 0, 0, 0); }
DI int crow(int i, int h) { return (i & 3) + 8 * (i >> 2) + 4 * h; }
DI f32x16 zero16() { f32x16 z; for (int i = 0; i < 16; ++i) z[i] = 0.f; return z; }
DI int lane_id() { int l; asm volatile("v_mbcnt_lo_u32_b32 %0, -1, 0\n\tv_mbcnt_hi_u32_b32 %0, -1, %0" : "=v"(l)); return l; }
DI int mk_tid(int wv) { return wv * 64 + lane_id(); }
DI float shx(float v, int m, int lane) { return __int_as_float(__builtin_amdgcn_ds_bpermute((lane ^ m) << 2, __float_as_int(v))); }
DI int shxi(int v, int m, int lane) { return __builtin_amdgcn_ds_bpermute((lane ^ m) << 2, v); }
DI float wave_sum(float v, int lane) { for (int o = 32; o > 0; o >>= 1) v += shx(v, o, lane); return v; }

constexpr size_t ws_al(size_t x) { return (x + 255) & ~(size_t)255; }
constexpr size_t OFF_w_ab_in = 0;
constexpr size_t OFF_w_ab_out = OFF_w_ab_in + ws_al(6144ull*2048*2);
constexpr size_t OFF_w_q0 = OFF_w_ab_out + ws_al(2048ull*2048*2);
constexpr size_t OFF_w_q1 = OFF_w_q0 + ws_al(2048ull*2048*2);
constexpr size_t OFF_w_cd_in = OFF_w_q1 + ws_al(2048ull*2048*2);
constexpr size_t OFF_w_cd_out = OFF_w_cd_in + ws_al(7680ull*2048*2);
constexpr size_t OFF_w_kv = OFF_w_cd_out + ws_al(2048ull*3072*2);
constexpr size_t OFF_utab = OFF_w_kv + ws_al(2048ull*256*2);
constexpr int TROW = 1536;
constexpr size_t OFF_vtab = OFF_utab + ws_al(2ull*16384*TROW);
constexpr size_t OFF_usc = OFF_vtab + ws_al(2ull*16384*TROW);
constexpr size_t OFF_vsc = OFF_usc + ws_al(2ull*16384*4);
constexpr size_t OFF_keys = OFF_vsc + ws_al(2ull*16384*4);
constexpr size_t OFF_xb = OFF_keys + ws_al(2ull*8*2*128*128*2);
constexpr size_t OFF_big = OFF_xb + ws_al(16384ull*2048*2);
constexpr size_t OFF_mixed = OFF_big + ws_al(16384ull*7680*2);
constexpr size_t OFF_r1 = OFF_mixed + ws_al(16384ull*3072*2);
constexpr size_t OFF_rope = OFF_r1 + ws_al(16384ull*2048*2);
constexpr size_t OFF_ssq0 = OFF_rope + ws_al(2048ull*32*2*4);
constexpr size_t OFF_ssq2 = OFF_ssq0 + ws_al(16384ull*4);
constexpr size_t OFF_ssqp = OFF_ssq2 + ws_al(16384ull*4);
constexpr size_t OFF_ssqc = OFF_ssqp + ws_al(16384ull*32*4);
constexpr size_t OFF_small = OFF_ssqc + ws_al(16384ull*4*4);
constexpr size_t OFF_r2 = OFF_small + ws_al(16384ull*256*4);
constexpr size_t OFF_btab = OFF_r2 + ws_al(256ull*32*2048*4);
constexpr size_t OFF_mask = OFF_btab + ws_al(8ull*132*4);
constexpr size_t OFF_xc = OFF_mask + ws_al(16384ull*64*4);
constexpr size_t OFF_dtb = OFF_xc + ws_al(16384ull*3072*2);
constexpr size_t OFF_csb = OFF_dtb + ws_al(16384ull*32*4);
constexpr size_t OFF_hbuf = OFF_csb + ws_al(16384ull*32*4);
constexpr size_t OFF_ctr = OFF_hbuf + ws_al(16384ull*2048*4);
constexpr size_t WS_TOTAL = OFF_ctr + ws_al(16384ull);

struct Params {
  const float *x, *rel_table, *ab_w_in, *ab_w_out, *ab_lambda, *ab_a_norm, *ab_b_norm, *cd_w_in, *cd_w_out, *cd_conv_w, *cd_conv_b,
      *cd_dt_bias, *cd_a_log, *cd_d_skip, *cd_ssm_norm, *cd_kv_norm, *cd_w_uk, *cd_w_uv, *norm_mix, *norm_ffn, *peer_w_q, *peer_keys,
      *peer_u, *peer_v, *norm_final;
  float* out;
  unsigned char* ws;
  int wv, pad;
  DI bf16_t* w_ab_in() const { return (bf16_t*)(ws + OFF_w_ab_in); }
  DI bf16_t* w_ab_out() const { return (bf16_t*)(ws + OFF_w_ab_out); }
  DI bf16_t* w_q0() const { return (bf16_t*)(ws + OFF_w_q0); }
  DI bf16_t* w_q1() const { return (bf16_t*)(ws + OFF_w_q1); }
  DI bf16_t* w_cd_in() const { return (bf16_t*)(ws + OFF_w_cd_in); }
  DI bf16_t* w_cd_out() const { return (bf16_t*)(ws + OFF_w_cd_out); }
  DI bf16_t* w_kv() const { return (bf16_t*)(ws + OFF_w_kv); }
  DI unsigned char* utab() const { return ws + OFF_utab; }
  DI unsigned char* vtab() const { return ws + OFF_vtab; }
  DI float* usc() const { return (float*)(ws + OFF_usc); }
  DI float* vsc() const { return (float*)(ws + OFF_vsc); }
  DI bf16_t* keys() const { return (bf16_t*)(ws + OFF_keys); }
  DI bf16_t* xb() const { return (bf16_t*)(ws + OFF_xb); }
  DI bf16_t* big() const { return (bf16_t*)(ws + OFF_big); }
  DI bf16_t* mixed() const { return (bf16_t*)(ws + OFF_mixed); }
  DI bf16_t* r1() const { return (bf16_t*)(ws + OFF_r1); }
  DI float* rope() const { return (float*)(ws + OFF_rope); }
  DI float* ssq0() const { return (float*)(ws + OFF_ssq0); }
  DI float* ssq2() const { return (float*)(ws + OFF_ssq2); }
  DI float* ssqp() const { return (float*)(ws + OFF_ssqp); }
  DI float* ssqc() const { return (float*)(ws + OFF_ssqc); }
  DI float* small() const { return (float*)(ws + OFF_small); }
  DI float* r2() const { return (float*)(ws + OFF_r2); }
  DI float* btab() const { return (float*)(ws + OFF_btab); }
  DI unsigned* mask() const { return (unsigned*)(ws + OFF_mask); }
  DI bf16_t* xc() const { return (bf16_t*)(ws + OFF_xc); }
  DI float* dtb() const { return (float*)(ws + OFF_dtb); }
  DI float* csb() const { return (float*)(ws + OFF_csb); }
  DI float* hbuf() const { return (float*)(ws + OFF_hbuf); }
  DI unsigned* ctr() const { return (unsigned*)(ws + OFF_ctr); }
};

#define XB_TMO      128
#define XB_XCNT(j)  (256  + 64 * (j))
#define XB_XSUB(j)  (1280 + 64 * (j))
#define XB_XGEN(j)  (2304 + 64 * (j))
#define XB_TOP      3328
#define XB_TOPGEN   3392
#define XCD_BAR_WORDS 3456
#define XB_SPIN_CAP (1u << 22)
DI unsigned xb_ld(unsigned* p) { return __hip_atomic_load(p, __ATOMIC_RELAXED, __HIP_MEMORY_SCOPE_AGENT); }
DI unsigned xb_add(unsigned* p, unsigned v) { return __hip_atomic_fetch_add(p, v, __ATOMIC_RELAXED, __HIP_MEMORY_SCOPE_AGENT); }
#define XB_SPIN(cond, bar) do { unsigned _sp = 0; while (cond) { __builtin_amdgcn_s_sleep(1); \
    if ((++_sp & 255u) == 0u) { if (xb_ld(&(bar)[XB_TMO])) break; if (_sp > XB_SPIN_CAP) { atomicAdd(&(bar)[XB_TMO], 1u); break; } } } } while (0)
struct GridBar {
  unsigned* bar; unsigned x; unsigned G; volatile LAS unsigned* st; int wv;
  DI void post() { x = (unsigned)__builtin_amdgcn_s_getreg((3 << 11) | 20) & 0xFu; if (wv == 0 && lane_id() == 0) (void)xb_add(&bar[XB_XCNT(x)], 1u); }
  DI void census(unsigned& nloc, unsigned& nx) const {
    unsigned sum, cnt, mine, sp = 0u;
    for (;;) {
      sum = 0u; cnt = 0u; mine = 0u;
#pragma unroll
      for (unsigned j = 0; j < 16; ++j) { const unsigned c = xb_ld(&bar[XB_XCNT(j)]); sum += c; cnt += (c > 0u) ? 1u : 0u; mine = (j == x) ? c : mine; }
      if (sum == G) break;
      __builtin_amdgcn_s_sleep(1);
      if ((++sp & 255u) == 0u) { if (xb_ld(&bar[XB_TMO])) break; if (sp > XB_SPIN_CAP) { atomicAdd(&bar[XB_TMO], 1u); break; } }
    }
    nloc = mine > 0u ? mine : 1u; nx = cnt > 0u ? cnt : 1u;
  }
  DI void xsync() {
    __syncthreads();
    if (wv == 0 && lane_id() == 0) {
      unsigned nloc = st[0], nx = st[1];
      if (nloc == 0u) { census(nloc, nx); st[0] = nloc; st[1] = nx; }
      const unsigned old = xb_add(&bar[3456 + 16 * x], 1u);
      const unsigned gen = old / nloc;
      if (old + 1u == (gen + 1u) * nloc) xb_add(&bar[3712 + 16 * x], 1u);
      else XB_SPIN(xb_ld(&bar[3712 + 16 * x]) == gen, bar);
    }
    __syncthreads();
  }
  DI void sync() {
    asm volatile("s_waitcnt vmcnt(0)" ::: "memory");
    __syncthreads();
    if (wv == 0 && lane_id() == 0) {
      __builtin_amdgcn_s_waitcnt(0);
      unsigned nloc = st[0], nx = st[1];
      if (nloc == 0u) { census(nloc, nx); st[0] = nloc; st[1] = nx; }
      const unsigned old = xb_add(&bar[XB_XSUB(x)], 1u);
      const unsigned gen = old / nloc;
      if (old + 1u == (gen + 1u) * nloc) {
        __builtin_amdgcn_fence(__ATOMIC_RELEASE, "agent");
        asm volatile("s_waitcnt vmcnt(0)" ::: "memory");
        const unsigned og = xb_add(&bar[XB_TOP], 1u);
        const unsigned tg = og / nx;
        if (og + 1u == (tg + 1u) * nx) xb_add(&bar[XB_TOPGEN], 1u);
        else XB_SPIN(xb_ld(&bar[XB_TOPGEN]) == tg, bar);
        __builtin_amdgcn_fence(__ATOMIC_ACQUIRE, "agent");
        xb_add(&bar[XB_XGEN(x)], 1u);
        asm volatile("s_waitcnt vmcnt(0)" ::: "memory");
      } else {
        XB_SPIN(xb_ld(&bar[XB_XGEN(x)]) == gen, bar);
        __builtin_amdgcn_fence(__ATOMIC_ACQUIRE, "agent");
        asm volatile("s_waitcnt vmcnt(0)" ::: "memory");
      }
    }
    __syncthreads();
  }
};
namespace pg8 {
constexpr int BM = 256, BK = 64, HALF = 128, HTB = HALF * BK * 2, STAGE_BYTES = 8 * HTB, NXCD = 8, WGM = 8;
DI int lds_byte(int r, int c) { const int st = (r >> 4) * 2 + (c >> 5), rr = r & 15, cc = c & 31, ob = rr * 64 + cc * 2; return st * 1024 + (ob ^ (((ob >> 9) & 1) << 5)); }
DI void stage_rc(int b, int& R, int& C) { const int st = b / 1024, sb = b % 1024, swz = sb ^ (((sb >> 9) & 1) << 5); R = (st >> 1) * 16 + swz / 64; C = (st & 1) * 32 + (swz % 64) / 2; }
DI int perm32(int rho) { const int n = rho >> 4, i = rho & 15; return 8 * (i >> 2) + 4 * n + (i & 3); }
struct Unit { int pm, pn; };
struct Gemm { const bf16_t* A; const bf16_t* Bt; int M, N, K, lda; };
struct StaticOrder {
  int nM, nN, nwg, G, c;
  DI void init(int M, int N, int G_, int c_) { nM = M / BM; nN = N / BM; nwg = nM * nN; G = G_; c = c_; }
  DI bool next(int i, Unit& u) const {
    const long L = (long)i * G + c; if (L >= nwg) return false;
    int wgid = (int)L; { const int q = nwg / NXCD, r = nwg % NXCD, xcd = wgid % NXCD, off = wgid / NXCD; wgid = (xcd < r ? xcd * (q + 1) : r * (q + 1) + (xcd - r) * q) + off; }
    const int nig = WGM * nN, gid = wgid / nig, fm = gid * WGM, gsz = (nM - fm) < WGM ? (nM - fm) : WGM;
    u.pm = fm + ((wgid % nig) % gsz); u.pn = (wgid % nig) / gsz; return true;
  }
};

template <class Epi>
DI void gemm_phase(LAS unsigned char* lds, const Gemm g, const StaticOrder& S, const Epi& E, const int wv) {
  const int tid = mk_tid(wv), wid = wv, lane = tid & 63, wr = wid >> 2, wc = wid & 3, fr = lane & 15, fq = lane >> 4;
  const int K = g.K, nt = K / BK, lda = g.lda;
  unsigned voffA[2], voffB[2];
#pragma unroll
  for (int i = 0; i < 2; ++i) { int R, C; stage_rc(tid * 16 + i * 8192, R, C); const int Rb = Epi::PERM ? ((R & ~31) + perm32(R & 31)) : R;
    voffA[i] = (unsigned)(R * lda + C) * 2u; voffB[i] = (unsigned)(Rb * K + C) * 2u; }
  const size_t kstep = (size_t)(BK * 2);
  const size_t hstepA = (size_t)HALF * lda * 2, hstepB = (size_t)HALF * K * 2;
  const size_t tstepA = 2 * hstepA, tstepB = 2 * hstepB;
  const unsigned ldsw = (unsigned)wid * 1024u;
  const int aoff = lds_byte(wr * 64 + fr, fq * 8), boff = lds_byte(wc * 32 + fr, fq * 8);
#define PG8_SA(b, h) (((b) * 2 + (h)) * HTB)
#define PG8_SB(b, h) ((4 + (b) * 2 + (h)) * HTB)
#define PG8_STAGE(bufoff, gbase, voff) do { _Pragma("unroll") for (int _i = 0; _i < 2; ++_i) \
        __builtin_amdgcn_global_load_lds((const unsigned*)((const char*)(gbase) + (voff)[_i]), (LAS unsigned*)(lds + (bufoff) + ldsw + _i * 8192), 16, 0, 0); } while (0)
#define PG8_LDA(dst, b, h) do { _Pragma("unroll") for (int m = 0; m < 4; ++m) _Pragma("unroll") for (int k = 0; k < 2; ++k) dst[m][k] = *(const LAS bf16x8*)(lds + PG8_SA(b, h) + aoff + m * 2048 + k * 1024); } while (0)
#define PG8_LDB(dst, b, h) do { _Pragma("unroll") for (int n = 0; n < 2; ++n) _Pragma("unroll") for (int k = 0; k < 2; ++k) dst[n][k] = *(const LAS bf16x8*)(lds + PG8_SB(b, h) + boff + n * 2048 + k * 1024); } while (0)
#define PG8_MMA(ai, bj, At, Bt) do { __builtin_amdgcn_s_setprio(1); _Pragma("unroll") for (int m = 0; m < 4; ++m) _Pragma("unroll") for (int n = 0; n < 2; ++n) _Pragma("unroll") for (int k = 0; k < 2; ++k) \
        acc[ai][bj][m][n] = __builtin_amdgcn_mfma_f32_16x16x32_bf16(Bt[n][k], At[m][k], acc[ai][bj][m][n], 0, 0, 0); __builtin_amdgcn_s_setprio(0); } while (0)
#define PG8_WAIT_V(n) asm volatile("s_waitcnt vmcnt(" #n ")" ::: "memory")
#define PG8_WAIT_L(n) asm volatile("s_waitcnt lgkmcnt(" #n ")" ::: "memory")
#define PG8_BAR __builtin_amdgcn_s_barrier()
#define PG8_SCHED __builtin_amdgcn_sched_barrier(0)
  Unit cur, nxt; int ui = 0;
  if (!S.next(0, cur)) return;
  f32x4 acc[2][2][4][2];
#pragma unroll
  for (int a = 0; a < 2; ++a)
#pragma unroll
    for (int b = 0; b < 2; ++b)
#pragma unroll
      for (int m = 0; m < 4; ++m)
#pragma unroll
        for (int n = 0; n < 2; ++n) acc[a][b][m][n] = (f32x4){0.f, 0.f, 0.f, 0.f};
  bf16x8 At[4][2], B0[2][2], B1[2][2];
  const char* cA = (const char*)g.A + (size_t)cur.pm * tstepA; const char* cB = (const char*)g.Bt + (size_t)cur.pn * tstepB;
  PG8_STAGE(PG8_SB(0, 0), cB, voffB); PG8_STAGE(PG8_SA(0, 0), cA, voffA); PG8_STAGE(PG8_SB(0, 1), cB + hstepB, voffB); PG8_STAGE(PG8_SA(0, 1), cA + hstepA, voffA);
  if (wr == 1) PG8_BAR;
  PG8_WAIT_V(4); PG8_BAR;
  PG8_STAGE(PG8_SB(1, 0), cB + kstep, voffB); PG8_STAGE(PG8_SA(1, 0), cA + kstep, voffA); PG8_STAGE(PG8_SB(1, 1), cB + hstepB + kstep, voffB);
  PG8_WAIT_V(6); PG8_BAR;
  for (;;) {
    const bool has_next = S.next(ui + 1, nxt);
    const char* nA = has_next ? (const char*)g.A + (size_t)nxt.pm * tstepA : cA; const char* nB = has_next ? (const char*)g.Bt + (size_t)nxt.pn * tstepB : cB;
    for (int t = 0; t < nt; t += 2) {
      const bool last = (t == nt - 2);
      const char* a1 = cA + (size_t)(t + 1) * kstep;
      const char* a2 = last ? nA : cA + (size_t)(t + 2) * kstep; const char* b2 = last ? nB : cB + (size_t)(t + 2) * kstep;
      const char* a3 = a2 + kstep; const char* b3 = b2 + kstep;
      PG8_LDB(B0, 0, 0); PG8_SCHED; PG8_LDA(At, 0, 0); PG8_STAGE(PG8_SA(1, 1), a1 + hstepA, voffA);
      PG8_WAIT_L(8); PG8_BAR; PG8_WAIT_L(0); PG8_MMA(0, 0, At, B0); PG8_BAR; PG8_SCHED;
      PG8_LDB(B1, 0, 1); PG8_STAGE(PG8_SB(0, 0), b2, voffB);
      PG8_BAR; PG8_WAIT_L(0); PG8_MMA(0, 1, At, B1); PG8_BAR;
      PG8_LDA(At, 0, 1); PG8_STAGE(PG8_SA(0, 0), a2, voffA);
      PG8_BAR; PG8_WAIT_L(0); PG8_MMA(1, 0, At, B0); PG8_BAR; PG8_SCHED;
      PG8_STAGE(PG8_SB(0, 1), b2 + hstepB, voffB);
      PG8_WAIT_V(6); PG8_BAR; PG8_MMA(1, 1, At, B1); PG8_BAR;
      PG8_LDB(B0, 1, 0); PG8_SCHED; PG8_LDA(At, 1, 0); PG8_STAGE(PG8_SA(0, 1), a2 + hstepA, voffA);
      PG8_WAIT_L(8); PG8_BAR; PG8_WAIT_L(0); PG8_MMA(0, 0, At, B0); PG8_BAR; PG8_SCHED;
      PG8_LDB(B1, 1, 1); PG8_STAGE(PG8_SB(1, 0), b3, voffB);
      PG8_BAR; PG8_WAIT_L(0); PG8_MMA(0, 1, At, B1); PG8_BAR;
      PG8_LDA(At, 1, 1); PG8_STAGE(PG8_SA(1, 0), a3, voffA);
      PG8_BAR; PG8_WAIT_L(0); PG8_MMA(1, 0, At, B0); PG8_BAR; PG8_SCHED;
      PG8_STAGE(PG8_SB(1, 1), b3 + hstepB, voffB);
      PG8_WAIT_V(6); PG8_BAR; PG8_MMA(1, 1, At, B1); PG8_BAR;
    }
    E(acc, cur, wr, wc, fr, fq);
    if (!has_next) break;
#pragma unroll
    for (int a = 0; a < 2; ++a)
#pragma unroll
      for (int b = 0; b < 2; ++b)
#pragma unroll
        for (int m = 0; m < 4; ++m)
#pragma unroll
          for (int n = 0; n < 2; ++n) acc[a][b][m][n] = (f32x4){0.f, 0.f, 0.f, 0.f};
    cur = nxt; cA = nA; cB = nB; ++ui;
  }
  PG8_WAIT_V(0);
  if (wr == 0) PG8_BAR;
  PG8_BAR;
#undef PG8_SA
#undef PG8_SB
#undef PG8_STAGE
#undef PG8_LDA
#undef PG8_LDB
#undef PG8_MMA
#undef PG8_WAIT_V
#undef PG8_WAIT_L
#undef PG8_BAR
#undef PG8_SCHED
}

#define EPI_PRELOAD_RS(expr) float rs8[8]; _Pragma("unroll") for (int ai = 0; ai < 2; ++ai) _Pragma("unroll") for (int m = 0; m < 4; ++m) { const int row = u.pm * 256 + 128 * ai + 64 * wr + 16 * m + fr; rs8[ai * 4 + m] = (expr); }
#define EPI_ROWS_BEGIN _Pragma("unroll") for (int ai = 0; ai < 2; ++ai) _Pragma("unroll") for (int m = 0; m < 4; ++m) { const int row = u.pm * 256 + 128 * ai + 64 * wr + 16 * m + fr;
#define EPI_COLS_BEGIN _Pragma("unroll") for (int bj = 0; bj < 2; ++bj) { const int col0 = u.pn * 256 + 128 * bj + 32 * wc + 8 * fq; float v[8]; \
      _Pragma("unroll") for (int j = 0; j < 4; ++j) { v[j] = acc[ai][bj][m][0][j]; v[4 + j] = acc[ai][bj][m][1][j]; }
DI void store8bf(bf16_t* p, const float (&v)[8]) { u32x4 w; w.x = pk2(v[0], v[1]); w.y = pk2(v[2], v[3]); w.z = pk2(v[4], v[5]); w.w = pk2(v[6], v[7]); *(u32x4*)p = w; }

struct EpiAbIn {
  static constexpr bool PERM = true;
  bf16_t* O; const float* ssq; const float* rope;
  DI void operator()(const f32x4 (&acc)[2][2][4][2], const Unit& u, int wr, int wc, int fr, int fq) const {
    const int pn = u.pn;
    EPI_PRELOAD_RS(ssq[row])
    EPI_ROWS_BEGIN
      const float rs = rsqrtf(rs8[ai * 4 + m] * (1.0f / 2048.0f) + EPSN); const int pos = row & 2047;
      EPI_COLS_BEGIN
#pragma unroll
        for (int j = 0; j < 8; ++j) v[j] *= rs;
        if (pn < 4) {
#pragma unroll
          for (int j = 0; j < 8; ++j) v[j] *= 0.125f * LOG2E;
        } else if (pn >= 12 && pn < 16) {
          const int f0 = (col0 & 63) >> 1;
          const f32x4 c0 = *(const f32x4*)(rope + (size_t)(pos * 32 + f0) * 2), c1 = *(const f32x4*)(rope + (size_t)(pos * 32 + f0) * 2 + 4);
          const float cs[4] = {c0[0], c0[2], c1[0], c1[2]}, sn[4] = {c0[1], c0[3], c1[1], c1[3]};
          float fac = 0.125f;
          if (pn >= 14) { const int hd = (col0 & 511) >> 6; const float lg = __log2f(1.0f - ex2(-5.0f - (float)hd)); fac = ex2(-(float)(pos & 63) * lg); }
#pragma unroll
          for (int i = 0; i < 4; ++i) { const float a = v[2 * i], b = v[2 * i + 1]; v[2 * i] = (a * cs[i] - b * sn[i]) * fac; v[2 * i + 1] = (a * sn[i] + b * cs[i]) * fac; }
        } else if (pn >= 20) {
#pragma unroll
          for (int j = 0; j < 8; ++j) v[j] = siluf(v[j]);
        }
        store8bf(O + (size_t)row * 6144 + col0, v);
      }
    }
  }
};

template <int NP> DI float row_ssq(const float* part, int row, int fq) {
  float s;
  if (NP == 32) { const f32x4 a = *(const f32x4*)(part + (size_t)row * 32 + fq * 8), b = *(const f32x4*)(part + (size_t)row * 32 + fq * 8 + 4); s = ((a[0] + a[1]) + (a[2] + a[3])) + ((b[0] + b[1]) + (b[2] + b[3])); }
  else s = part[(size_t)row * 4 + fq];
  const int lane = lane_id();
  s += shx(s, 16, lane); s += shx(s, 32, lane);
  return s;
}

struct EpiRes {
  static constexpr bool PERM = true;
  const float* resid; float* out; bf16_t* xb; float* ssq;
  DI void operator()(const f32x4 (&acc)[2][2][4][2], const Unit& u, int wr, int wc, int fr, int fq) const {
#pragma unroll
    for (int ai = 0; ai < 2; ++ai) {
      asm volatile("" ::: "memory");
      f32x4 rr[4][2][2];
#pragma unroll
      for (int m = 0; m < 4; ++m)
#pragma unroll
        for (int bj = 0; bj < 2; ++bj) {
          const size_t off = (size_t)(u.pm * 256 + 128 * ai + 64 * wr + 16 * m + fr) * 2048 + u.pn * 256 + 128 * bj + 32 * wc + 8 * fq;
          rr[m][bj][0] = *(const f32x4*)(resid + off); rr[m][bj][1] = *(const f32x4*)(resid + off + 4);
        }
#pragma unroll
      for (int m = 0; m < 4; ++m) {
        const int row = u.pm * 256 + 128 * ai + 64 * wr + 16 * m + fr;
        float ss = 0.f;
#pragma unroll
        for (int bj = 0; bj < 2; ++bj) {
          const size_t off = (size_t)row * 2048 + u.pn * 256 + 128 * bj + 32 * wc + 8 * fq;
          float v[8];
#pragma unroll
          for (int j = 0; j < 4; ++j) { v[j] = acc[ai][bj][m][0][j] + rr[m][bj][0][j]; v[4 + j] = acc[ai][bj][m][1][j] + rr[m][bj][1][j]; }
#pragma unroll
          for (int j = 0; j < 8; ++j) ss += v[j] * v[j];
          store8bf(xb + off, v);
        }
        ss += shx(ss, 16, fr + 16 * fq); ss += shx(ss, 32, fr + 16 * fq);
        if (fq == 0) ssq[(size_t)row * 32 + u.pn * 4 + wc] = ss;
      }
    }
  }
};

template <int NP> struct EpiScale {
  static constexpr bool PERM = true;
  bf16_t* O; int ldo; const float* ssq; float invn;
  DI void operator()(const f32x4 (&acc)[2][2][4][2], const Unit& u, int wr, int wc, int fr, int fq) const {
    EPI_PRELOAD_RS(row_ssq<NP>(ssq, row, fq))
    EPI_ROWS_BEGIN
      const float rs = rsqrtf(rs8[ai * 4 + m] * invn + EPSN);
      EPI_COLS_BEGIN
#pragma unroll
        for (int j = 0; j < 8; ++j) v[j] *= rs;
        store8bf(O + (size_t)row * ldo + col0, v);
      }
    }
  }
};

struct EpiCdIn {
  static constexpr bool PERM = true;
  bf16_t* O; const float* ssq; float* small; float* ssqc;
  DI void operator()(const f32x4 (&acc)[2][2][4][2], const Unit& u, int wr, int wc, int fr, int fq) const {
    const int pn = u.pn;
    EPI_PRELOAD_RS(ssq[row])
    EPI_ROWS_BEGIN
      const float rs = rsqrtf(rs8[ai * 4 + m] * (1.0f / 2048.0f) + EPSN);
      float ss = 0.f;
      EPI_COLS_BEGIN
#pragma unroll
        for (int j = 0; j < 8; ++j) v[j] *= rs;
        if (pn < 8) {
#pragma unroll
          for (int j = 0; j < 8; ++j) v[j] = siluf(v[j]);
        } else if (pn >= 20 && pn < 24) {
#pragma unroll
          for (int j = 0; j < 8; ++j) v[j] *= 0.08838834764831845f * LOG2E;
        } else if (pn == 28) {
#pragma unroll
          for (int j = 0; j < 8; ++j) ss += v[j] * v[j];
        } else if (pn == 29) {
          float* sp = small + (size_t)row * 256 + (col0 - 7424);
          *(f32x4*)sp = (f32x4){v[0], v[1], v[2], v[3]}; *(f32x4*)(sp + 4) = (f32x4){v[4], v[5], v[6], v[7]};
        }
        store8bf(O + (size_t)row * 7680 + col0, v);
      }
      if (pn == 28) { ss += shx(ss, 16, fr + 16 * fq); ss += shx(ss, 32, fr + 16 * fq); if (fq == 0) ssqc[(size_t)row * 4 + wc] = ss; }
    }
  }
};
}
DI int cd_src_col(int n) {
  if (n < 5120) return n;
  if (n < 6144) return n - 5120 + 5152;
  if (n < 7168) return n - 6144 + 6432;
  if (n < 7424) return n - 7168 + 6176;
  if (n < 7488) return n - 7424 + 7456;
  if (n < 7520) return n - 7488 + 5120;
  if (n < 7536) return n;
  return -1;
}
struct IdMap { DI int operator()(int n) const { return n; } };
struct CdMap { DI int operator()(int n) const { return cd_src_col(n); } };

template <class CM>
DI void prep_wT(LAS float* tile, const float* W, int K, int ldw, bf16_t* dst, int Ndst, const float* gain, CM cm, const int wv, int id0 = -1, int id1 = 0) {
  const int tid = mk_tid(wv), ntk = K / 64, ntn = Ndst / 128;
  const int ib = id0 < 0 ? (int)blockIdx.x : id0, ie = id0 < 0 ? ntk * ntn : id1, is = id0 < 0 ? (int)gridDim.x : 1;
  for (int id = ib; id < ie; id += is) {
    const int k0 = (id % ntk) * 64, n0 = (id / ntk) * 128;
    f32x4 v4[4];
#pragma unroll
    for (int i = 0; i < 4; ++i) {
      const int idx = tid + 512 * i, kk = idx >> 5, c4 = idx & 31, sc = cm(n0 + c4 * 4);
      v4[i] = (f32x4){0.f, 0.f, 0.f, 0.f};
      if (sc >= 0) v4[i] = *(const f32x4*)(W + (size_t)(k0 + kk) * ldw + sc);
      if (gain) v4[i] *= gain[k0 + kk];
    }
#pragma unroll
    for (int i = 0; i < 4; ++i) {
      const int idx = tid + 512 * i, kk = idx >> 5, c4 = idx & 31;
#pragma unroll
      for (int j = 0; j < 4; ++j) tile[kk * 129 + c4 * 4 + j] = v4[i][j];
    }
    __syncthreads();
#pragma unroll
    for (int i = 0; i < 2; ++i) {
      const int idx = tid + 512 * i, nn = idx >> 3, kc = (idx & 7) * 8; float v[8];
#pragma unroll
      for (int j = 0; j < 8; ++j) v[j] = tile[(kc + j) * 129 + nn];
      pg8::store8bf(dst + (size_t)(n0 + nn) * K + k0 + kc, v);
    }
    __syncthreads();
  }
}

DI void cvt_copy(const float* src, bf16_t* dst, size_t n8, const int wv) {
  for (size_t i = (size_t)blockIdx.x * 512 + mk_tid(wv); i < n8; i += (size_t)gridDim.x * 512) {
    const f32x4 a = *(const f32x4*)(src + i * 8), b = *(const f32x4*)(src + i * 8 + 4);
    const float v[8] = {a[0], a[1], a[2], a[3], b[0], b[1], b[2], b[3]};
    pg8::store8bf(dst + i * 8, v);
  }
}

DI void cvt_fp6_rows(const float* src, unsigned char* dst, float* scale, int row0, int row1, const int wv) {
  const int tid = mk_tid(wv), w = tid >> 6, lane = tid & 63;
  for (int row = row0 + w; row < row1; row += 8) {
    float v[32]; float amax = 0.f;
#pragma unroll
    for (int i = 0; i < 4; ++i) {
      const f32x4 a = *(const f32x4*)(src + (size_t)row * 2048 + 512 * i + 8 * lane), b = *(const f32x4*)(src + (size_t)row * 2048 + 512 * i + 8 * lane + 4);
#pragma unroll
      for (int j = 0; j < 4; ++j) { v[8 * i + j] = a[j]; v[8 * i + 4 + j] = b[j]; amax = fmaxf(amax, fmaxf(fabsf(a[j]), fabsf(b[j]))); }
    }
    for (int o = 32; o > 0; o >>= 1) amax = fmaxf(amax, shx(amax, o, lane));
    const unsigned ab = __float_as_uint(amax);
    int e = 0;
    if (amax > 0.f) { const int ex = (int)((ab >> 23) & 255u) - 126; const float mant = __uint_as_float((ab & 0x7fffffu) | 0x3f000000u); e = (mant <= 0.9375f) ? ex - 3 : ex - 2; }
    e = max(e, -126);
    const float inv = __uint_as_float((unsigned)(127 - e) << 23);
    f32x16 lo, hi;
#pragma unroll
    for (int k = 0; k < 16; ++k) { lo[k] = v[k] * inv; hi[k] = v[16 + k] * inv; }
    const u32x6 p = __builtin_amdgcn_cvt_scalef32_2xpk16_fp6_f32(lo, hi, 1.0f);
    *(u32x4*)(dst + (size_t)row * TROW + lane * 16) = (u32x4){p[0], p[1], p[2], p[3]};
    *(u32x2*)(dst + (size_t)row * TROW + 1024 + lane * 8) = (u32x2){p[4], p[5]};
    if (lane == 0) scale[row] = __uint_as_float((unsigned)(e + 127) << 23);
  }
}

__device__ const double kRopeInv[32] = {1.0, 0.7498942093324559, 0.5623413251903491, 0.4216965034285822, 0.31622776601683794, 0.23713737056616552, 0.1778279410038923,
  0.1333521432163324, 0.1, 0.07498942093324558, 0.05623413251903491, 0.042169650342858224, 0.03162277660168379, 0.023713737056616554, 0.01778279410038923, 0.01333521432163324,
  0.01, 0.007498942093324558, 0.005623413251903491, 0.004216965034285823, 0.0031622776601683794, 0.0023713737056616554, 0.0017782794100389228, 0.001333521432163324, 0.001,
  0.0007498942093324559, 0.0005623413251903491, 0.00042169650342858224, 0.00031622776601683794, 0.00023713737056616554, 0.00017782794100389227, 0.0001333521432163324};

DI int rel_bucket_dev(int n) {
  if (n < 16) return n;
  int bkt = 16;
  bkt += (n >= 19) + (n >= 21) + (n >= 24) + (n >= 27) + (n >= 31) + (n >= 35) + (n >= 40) + (n >= 46) + (n >= 52) + (n >= 59) + (n >= 67) + (n >= 77) + (n >= 87) + (n >= 99) + (n >= 113);
  return bkt;
}

constexpr int N_CVT_ITEMS = 264 + 1024;
constexpr int N_CVT_LATE = 256;
DI void cvt_item(const Params& P, LAS unsigned char* lds, int it) {
  LAS float* tile = (LAS float*)lds;
  const int wv = P.wv;
  __syncthreads();
  if (it < 32) prep_wT(tile, P.ab_w_out, 2048, 2048, P.w_ab_out(), 2048, nullptr, IdMap(), wv, it * 16, it * 16 + 16);
  else if (it < 64) prep_wT(tile, P.peer_w_q, 2048, 2048, P.w_q0(), 2048, P.norm_ffn, IdMap(), wv, (it - 32) * 16, (it - 32) * 16 + 16);
  else if (it < 96) prep_wT(tile, P.peer_w_q + (size_t)2048 * 2048, 2048, 2048, P.w_q1(), 2048, P.norm_ffn + 2048, IdMap(), wv, (it - 64) * 16, (it - 64) * 16 + 16);
  else if (it < 216) prep_wT(tile, P.cd_w_in, 2048, 7536, P.w_cd_in(), 7680, P.norm_mix + 2048, CdMap(), wv, (it - 96) * 16, (it - 96) * 16 + 16);
  else if (it < 264) prep_wT(tile, P.cd_w_out, 3072, 2048, P.w_cd_out(), 2048, nullptr, IdMap(), wv, (it - 216) * 16, (it - 216) * 16 + 16);
  else {
    const int r = (it - 264) * 64;
    if (r < 32768) cvt_fp6_rows(P.peer_u, P.utab(), P.usc(), r, r + 64, wv);
    else cvt_fp6_rows(P.peer_v, P.vtab(), P.vsc(), r - 32768, r - 32768 + 64, wv);
  }
}

DI void phase_prep(const Params& P, LAS unsigned char* lds) {
  const int wv = P.wv, tid = mk_tid(wv), lane = tid & 63, w = tid >> 6;
  const size_t gtid = (size_t)blockIdx.x * 512 + tid, gsz = (size_t)gridDim.x * 512;
  for (int row0 = (blockIdx.x * 8 + w) * 2; row0 < T_TOK; row0 += gridDim.x * 16) {
    f32x4 ra[2][4][2];
#pragma unroll
    for (int rr = 0; rr < 2; ++rr)
#pragma unroll
      for (int i = 0; i < 4; ++i) { const size_t off = (size_t)(row0 + rr) * 2048 + 512 * i + 8 * lane; ra[rr][i][0] = *(const f32x4*)(P.x + off); ra[rr][i][1] = *(const f32x4*)(P.x + off + 4); }
#pragma unroll
    for (int rr = 0; rr < 2; ++rr) {
      float ss = 0.f;
#pragma unroll
      for (int i = 0; i < 4; ++i) {
        const size_t off = (size_t)(row0 + rr) * 2048 + 512 * i + 8 * lane;
        const f32x4 a = ra[rr][i][0], b = ra[rr][i][1];
        const float v[8] = {a[0], a[1], a[2], a[3], b[0], b[1], b[2], b[3]};
#pragma unroll
        for (int j = 0; j < 8; ++j) ss += v[j] * v[j];
        pg8::store8bf(P.xb() + off, v);
      }
      ss = wave_sum(ss, lane);
      if (lane == 0) P.ssq0()[row0 + rr] = ss;
    }
  }
  LAS float* tile = (LAS float*)lds;
  prep_wT(tile, P.ab_w_in, 2048, 6144, P.w_ab_in(), 6144, P.norm_mix, IdMap(), wv);
  for (size_t i = gtid; i < (size_t)2048 * 256; i += gsz) {
    const int n = (int)(i >> 8), c = (int)(i & 255);
    float v;
    if (n < 1024) v = P.cd_w_uk[(size_t)n * 256 + c];
    else { const int hh = (n - 1024) >> 7, d = (n - 1024) & 127; v = P.cd_w_uv[((size_t)hh * 256 + c) * 128 + d]; }
    v *= P.cd_kv_norm[c];
    P.w_kv()[i] = (bf16_t)(pk2(v, 0.f) & 0xffffu);
  }
  for (size_t i = gtid; i < (size_t)2048 * 32; i += gsz) {
    const int pos = (int)(i >> 5), f = (int)(i & 31);
    const double rev = (double)pos * kRopeInv[f] * 0.15915494309189535;
    const float fr = (float)(rev - floor(rev));
    P.rope()[i * 2] = __builtin_amdgcn_cosf(fr); P.rope()[i * 2 + 1] = __builtin_amdgcn_sinf(fr);
  }
  for (size_t i = gtid; i < (size_t)8 * 132; i += gsz) {
    const int hh = (int)(i / 132), d = (int)(i % 132);
    const int bk = d >= 128 ? 31 : rel_bucket_dev(d);
    P.btab()[i] = P.rel_table[bk * 8 + hh] * LOG2E;
  }
  cvt_copy(P.peer_keys, P.keys(), (size_t)2 * 8 * 2 * 128 * 128 / 8, wv);
}
DI int next_item(unsigned* ctr, LAS int* slot, const int wv) {
  __syncthreads();
  if (wv == 0 && lane_id() == 0) *slot = (int)atomicAdd(ctr, 1u);
  __syncthreads();
  return *slot;
}
DI bf16x8 pack8(const f32x16& x, const int s2) {
  u32x4 p; p.x = pk2(x[8 * s2 + 0], x[8 * s2 + 1]); p.y = pk2(x[8 * s2 + 2], x[8 * s2 + 3]); p.z = pk2(x[8 * s2 + 4], x[8 * s2 + 5]); p.w = pk2(x[8 * s2 + 6], x[8 * s2 + 7]);
  return __builtin_bit_cast(bf16x8, p);
}
DI bf16x8 tr_pair(const LAS unsigned char* p, int hi_off) {
  const s16x4 lo = __builtin_amdgcn_ds_read_tr16_b64_v4i16((LAS s16x4*)p);
  const s16x4 hi = __builtin_amdgcn_ds_read_tr16_b64_v4i16((LAS s16x4*)(p + hi_off));
  return __builtin_shufflevector(lo, hi, 0, 1, 2, 3, 4, 5, 6, 7);
}

template <int DH, int MODE>
DI void attn_core(LAS unsigned char* lds, const bf16_t* Qg, int ldq, const bf16_t* Kg, int ldk, const bf16_t* Vg, int ldv, int q0,
                  const unsigned* maskb, float lg2gamma, const LAS float* btab, f32x16 (&o)[4], float& lsum, const int wv) {
  const int tid = mk_tid(wv), w = tid >> 6, lane = tid & 63, r = lane & 31, h = lane >> 5;
  const int tq = q0 + 32 * w + r;
  constexpr int SUP = (DH == 64) ? 2 : 1, ROWS = 64 * SUP;
  constexpr int KS = DH / 16, KSTR = DH * 2 + 16, KBUF = ROWS * KSTR, VSTR = 320, VBUF = ROWS * VSTR, BUF = KBUF + VBUF;
  constexpr int KCH = DH / 8, NK = (ROWS * KCH) / 512, NV = (ROWS * 16) / 512;
  constexpr bool QLDS = (DH == 128);
  constexpr int QOFF = 80000, QSTRB = DH * 2 + 16;
  bf16x8 bq[QLDS ? 1 : KS];
  if (QLDS) {
#pragma unroll
    for (int s = 0; s < KS; ++s) *(LAS bf16x8*)(lds + QOFF + (32 * w + r) * QSTRB + (16 * s + 8 * h) * 2) = *(const bf16x8*)(Qg + (size_t)tq * ldq + 16 * s + 8 * h);
  } else {
#pragma unroll
    for (int s = 0; s < KS; ++s) bq[QLDS ? 0 : s] = *(const bf16x8*)(Qg + (size_t)tq * ldq + 16 * s + 8 * h);
  }
  const int nkt = (q0 + 256) >> 6, my_last = (q0 + 32 * w + 31) >> 6;
  u32x4 kreg[NK], vreg[NV];
  auto load_tile = [&](int stl) {
#pragma unroll
    for (int i = 0; i < NK; ++i) { const int c = tid + 512 * i, row = c / KCH, ch = c % KCH; kreg[i] = *(const u32x4*)(Kg + (size_t)(stl * ROWS + row) * ldk + ch * 8); }
#pragma unroll
    for (int i = 0; i < NV; ++i) { const int c = tid + 512 * i, row = c >> 4, ch = c & 15; vreg[i] = *(const u32x4*)(Vg + (size_t)(stl * ROWS + row) * ldv + ch * 8); }
  };
  auto write_tile = [&](int b) {
#pragma unroll
    for (int i = 0; i < NK; ++i) { const int c = tid + 512 * i, row = c / KCH, ch = c % KCH; *(LAS u32x4*)(lds + b * BUF + row * KSTR + ch * 16) = kreg[i]; }
#pragma unroll
    for (int i = 0; i < NV; ++i) { const int c = tid + 512 * i, row = c >> 4, ch = c & 15; *(LAS u32x4*)(lds + b * BUF + KBUF + row * VSTR + ch * 16) = vreg[i]; }
  };
  float mrun = -__builtin_inff();
  lsum = 0.f;
#pragma unroll
  for (int d = 0; d < 4; ++d) o[d] = zero16();
  const int vtr = (4 * h + ((lane & 15) >> 2)) * VSTR + (16 * ((lane >> 4) & 1) + 4 * (lane & 3)) * 2;
  __syncthreads();
  load_tile(0); write_tile(0);
  __syncthreads();
  const int nst = nkt / SUP;
  for (int stl = 0; stl < nst; ++stl) {
    if (stl + 1 < nst) load_tile(stl + 1);
#pragma unroll 1
    for (int hf = 0; hf < SUP; ++hf) {
    const int kt = stl * SUP + hf;
    if (kt <= my_last) {
      const LAS unsigned char* kb_base = lds + (stl & 1) * BUF + hf * 64 * KSTR;
      const LAS unsigned char* vb_base = lds + (stl & 1) * BUF + KBUF + hf * 64 * VSTR;
      const int k0 = kt * 64;
      f32x16 st[2];
      __builtin_amdgcn_s_setprio(1);
#pragma unroll
      for (int kb = 0; kb < 2; ++kb) {
        st[kb] = zero16();
#pragma unroll
        for (int s = 0; s < KS; ++s) {
          const bf16x8 kf = *(const LAS bf16x8*)(kb_base + (32 * kb + r) * KSTR + (16 * s + 8 * h) * 2);
          const bf16x8 qf = QLDS ? *(const LAS bf16x8*)(lds + QOFF + (32 * w + r) * QSTRB + (16 * s + 8 * h) * 2) : bq[QLDS ? 0 : s];
          st[kb] = mfma32(kf, qf, st[kb]);
        }
        if (QLDS) __builtin_amdgcn_sched_barrier(0);
      }
      __builtin_amdgcn_s_setprio(0);
      if (MODE == 1) {
        const float a_t = ex2((float)(tq - k0) * lg2gamma);
        const bool diag = (k0 + 63 > q0 + 32 * w);
#pragma unroll
        for (int kb = 0; kb < 2; ++kb)
#pragma unroll
          for (int i = 0; i < 16; ++i) {
            const int key = k0 + 32 * kb + crow(i, h);
            float v = st[kb][i] * a_t;
            if (diag && key > tq) v = 0.f;
            st[kb][i] = v;
          }
      } else {
        const bool near = ((q0 + 32 * w) - (k0 + 63)) < 128;
        unsigned mw[2] = {0xffffffffu, 0xffffffffu};
        if (MODE == 2) { const u32x2 m2 = *(const u32x2*)(maskb + (size_t)tq * 64 + kt * 2); mw[0] = m2.x >> (4 * h); mw[1] = m2.y >> (4 * h); }
        const float ninf = -__builtin_inff();
        if (near) {
#pragma unroll
          for (int kb = 0; kb < 2; ++kb)
#pragma unroll
            for (int i = 0; i < 16; ++i) {
              const int d = tq - (k0 + 32 * kb + crow(i, h));
              const int idx = min(max(d, 0), 128);
              float z = st[kb][i] + btab[idx];
              if (d < 0) z = ninf;
              if (MODE == 2) { if (!((mw[kb] >> ((i & 3) + 8 * (i >> 2))) & 1u)) z = ninf; }
              st[kb][i] = z;
              if (QLDS && i == 15) __builtin_amdgcn_sched_barrier(0);
            }
        } else {
          if (MODE == 2) {
#pragma unroll
            for (int kb = 0; kb < 2; ++kb)
#pragma unroll
              for (int i = 0; i < 16; ++i) if (!((mw[kb] >> ((i & 3) + 8 * (i >> 2))) & 1u)) st[kb][i] = ninf;
          }
        }
        float mx = st[0][0];
#pragma unroll
        for (int kb = 0; kb < 2; ++kb)
#pragma unroll
          for (int i = 0; i < 16; ++i) mx = fmaxf(mx, st[kb][i]);
        mx = fmaxf(mx, shx(mx, 32, lane));
        const float mnew = fmaxf(mrun, mx), msafe = fmaxf(mnew, -1e30f);
        const bool grow = __ballot(mnew > mrun) != 0ull;
        if (grow) {
          const float alpha = ex2(mrun - msafe);
          lsum *= alpha;
#pragma unroll
          for (int d = 0; d < 4; ++d)
#pragma unroll
            for (int i = 0; i < 16; ++i) o[d][i] *= alpha;
        }
        mrun = mnew;
        float rs = 0.f;
#pragma unroll
        for (int kb = 0; kb < 2; ++kb)
#pragma unroll
          for (int i = 0; i < 16; ++i) { const float p = ex2(st[kb][i] - msafe); st[kb][i] = p; rs += p; }
        lsum += rs;
      }
      __builtin_amdgcn_s_setprio(1);
#pragma unroll
      for (int kb = 0; kb < 2; ++kb)
#pragma unroll
        for (int s2 = 0; s2 < 2; ++s2) {
          const bf16x8 pb = pack8(st[kb], s2);
          const LAS unsigned char* vp = vb_base + vtr + (32 * kb + 16 * s2) * VSTR;
#pragma unroll
          for (int d = 0; d < 4; ++d) {
            const bf16x8 vf = tr_pair(vp + d * 64, 8 * VSTR);
            o[d] = mfma32(vf, pb, o[d]);
          }
          if (kb == 0 && s2 == 1) __builtin_amdgcn_sched_barrier(0);
        }
      __builtin_amdgcn_s_setprio(0);
    }
    }
    if (stl + 1 < nst) write_tile((stl + 1) & 1);
    __syncthreads();
  }
}

DI void attn_ab_item(const Params& P, LAS unsigned char* lds, int item, float lam) {
  const int grp = item >> 6, bh = item & 63, b = bh >> 3, hh = bh & 7;
  const int jt[16] = {7, 6, 5, 4, 3, 7, 6, 2, 5, 4, 1, 3, 2, 0, 1, 0};
  const bool isret = ((0xDB60 >> grp) & 1) != 0;
  int j = 0;
#pragma unroll
  for (int g = 0; g < 16; ++g) if (g == grp) j = jt[g];
  const int q0 = j * 256;
  const int tid = mk_tid(P.wv), w = tid >> 6, lane = tid & 63, r = lane & 31, h = lane >> 5;
  const int tq = q0 + 32 * w + r;
  const bf16_t* base = P.big() + (size_t)b * 2048 * 6144;
  LAS float* btab = (LAS float*)(lds + 150016);
  const LAS float* nrm = (const LAS float*)(lds + 151040);
  f32x16 o[4]; float lsum;
  if (!isret) {
    __syncthreads();
    if (tid < 132) btab[tid] = P.btab()[hh * 132 + tid] - P.btab()[hh * 132 + 128];
    float* stash = P.r2() + (size_t)(blockIdx.x * 8 + w) * 4096 + lane * 4;
#pragma unroll 1
    for (int mp = 0; mp < 2; ++mp) {
      attn_core<64, 0>(lds, base + hh * 128 + 64 * mp, 6144, base + 1024 + hh * 128 + 64 * mp, 6144, base + 2048 + hh * 128, 6144, q0, nullptr, 0.f, btab, o, lsum, P.wv);
      if (mp == 0) {
        const float inv0 = 1.0f / (lsum + shx(lsum, 32, lane));
#pragma unroll
        for (int d = 0; d < 4; ++d)
#pragma unroll
          for (int i = 0; i < 16; ++i) stash[((d * 16 + i) >> 2) * 256 + (i & 3)] = o[d][i] * inv0;
      }
    }
    const float inv = 1.0f / (lsum + shx(lsum, 32, lane));
    float ss = 0.f;
#pragma unroll
    for (int d = 0; d < 4; ++d)
#pragma unroll
      for (int i = 0; i < 16; ++i) { const float v = stash[((d * 16 + i) >> 2) * 256 + (i & 3)] - lam * o[d][i] * inv; o[d][i] = v; ss += v * v; if ((i & 7) == 7) asm volatile("" ::: "memory"); }
    ss += shx(ss, 32, lane);
    const float rstd = rsqrtf(ss * (1.0f / 128.0f) + EPSN) * 0.8f;
    bf16_t* orow = P.mixed() + (size_t)(b * 2048 + tq) * 2048 + hh * 128;
#pragma unroll
    for (int d = 0; d < 4; ++d)
#pragma unroll
      for (int g = 0; g < 4; ++g) {
        const int dv0 = 32 * d + 8 * g + 4 * h;
        const f32x4 an = *(const LAS f32x4*)(nrm + dv0);
        u32x2 wv; wv.x = pk2(o[d][4 * g] * rstd * an[0], o[d][4 * g + 1] * rstd * an[1]); wv.y = pk2(o[d][4 * g + 2] * rstd * an[2], o[d][4 * g + 3] * rstd * an[3]);
        *(u32x2*)(orow + dv0) = wv;
        asm volatile("" ::: "memory");
      }
  } else {
    const float lg = __log2f(1.0f - ex2(-5.0f - (float)hh));
    attn_core<64, 1>(lds, base + 3072 + hh * 64, 6144, base + 3584 + hh * 64, 6144, base + 4096 + hh * 128, 6144, q0, nullptr, lg, btab, o, lsum, P.wv);
    float ss = 0.f;
#pragma unroll
    for (int d = 0; d < 4; ++d)
#pragma unroll
      for (int i = 0; i < 16; ++i) ss += o[d][i] * o[d][i];
    ss += shx(ss, 32, lane);
    const float rstd = rsqrtf(ss * (1.0f / 128.0f) + EPSN);
    const bf16_t* grow = base + (size_t)tq * 6144 + 5120 + hh * 128;
    bf16_t* orow = P.mixed() + (size_t)(b * 2048 + tq) * 2048 + 1024 + hh * 128;
#pragma unroll
    for (int d = 0; d < 4; ++d)
#pragma unroll
      for (int g = 0; g < 4; ++g) {
        const int dv0 = 32 * d + 8 * g + 4 * h;
        const f32x4 bn = *(const LAS f32x4*)(nrm + 128 + dv0);
        const u32x2 gg = *(const u32x2*)(grow + dv0);
        u32x2 wv; wv.x = pk2(o[d][4 * g] * rstd * bn[0] * bflo(gg.x), o[d][4 * g + 1] * rstd * bn[1] * bfhi(gg.x));
        wv.y = pk2(o[d][4 * g + 2] * rstd * bn[2] * bflo(gg.y), o[d][4 * g + 3] * rstd * bn[3] * bfhi(gg.y));
        *(u32x2*)(orow + dv0) = wv;
        asm volatile("" ::: "memory");
      }
  }
}

DI void phase_attn_ab(const Params& P, LAS unsigned char* lds) {
  LAS int* slot = (LAS int*)(lds + 163000);
  float lam;
  { const int lane = lane_id();
    const float a = P.ab_lambda[lane] * P.ab_lambda[64 + lane], b = P.ab_lambda[128 + lane] * P.ab_lambda[192 + lane];
    lam = __expf(wave_sum(a, lane)) - __expf(wave_sum(b, lane)) + 0.2f; }
  { const int t = mk_tid(P.wv); if (t < 256) ((LAS float*)(lds + 151040))[t] = t < 128 ? P.ab_a_norm[t] : P.ab_b_norm[t - 128]; }
  for (;;) {
    const int s = next_item(P.ctr() + 0, slot, P.wv);
    if (s >= 1024 + N_CVT_ITEMS - N_CVT_LATE) break;
    if (s < 2048) { if (s & 1) cvt_item(P, lds, s >> 1); else attn_ab_item(P, lds, s >> 1, lam); }
    else cvt_item(P, lds, 1024 + (s - 2048));
  }
}

DI void dsa_attn_item(const Params& P, LAS unsigned char* lds, int item) {
  const int j = 7 - (item >> 6), bh = item & 63, b = bh >> 3, hh = bh & 7, q0 = j * 256;
  const int tid = mk_tid(P.wv), w = tid >> 6, lane = tid & 63, r = lane & 31, h = lane >> 5;
  const int tq = q0 + 32 * w + r;
  LAS float* btab = (LAS float*)(lds + 150016);
  __syncthreads();
  if (tid < 132) btab[tid] = P.btab()[hh * 132 + tid] - P.btab()[hh * 132 + 128];
  f32x16 o[4]; float lsum;
  const bf16_t* qb = P.big() + (size_t)b * 2048 * 7680 + 5120 + hh * 128;
  const bf16_t* kv = P.r1() + (size_t)b * 2048 * 2048;
  attn_core<128, 2>(lds, qb, 7680, kv + hh * 128, 2048, kv + 1024 + hh * 128, 2048, q0, P.mask() + (size_t)b * 2048 * 64, 0.f, btab, o, lsum, P.wv);
  const float inv = 1.0f / (lsum + shx(lsum, 32, lane));
  bf16_t* orow = P.mixed() + (size_t)(b * 2048 + tq) * 3072 + 2048 + hh * 128;
#pragma unroll
  for (int d = 0; d < 4; ++d)
#pragma unroll
    for (int g = 0; g < 4; ++g) {
      const int dv0 = 32 * d + 8 * g + 4 * h;
      u32x2 wv; wv.x = pk2(o[d][4 * g] * inv, o[d][4 * g + 1] * inv); wv.y = pk2(o[d][4 * g + 2] * inv, o[d][4 * g + 3] * inv);
      *(u32x2*)(orow + dv0) = wv;
    }
}
DI unsigned ord_key(float f) { const unsigned b = __float_as_uint(f); return b ^ ((b & 0x80000000u) ? 0xffffffffu : 0x80000000u); }

DI void dsa_index_item(const Params& P, LAS unsigned char* lds, int item) {
  const int qb = 63 - (item >> 3), b = item & 7;
  const int tid = mk_tid(P.wv), w = tid >> 6, lane = tid & 63, r = lane & 31, h = lane >> 5;
  const int tq0 = qb * 32;
  const bf16_t* cd = P.big() + (size_t)b * 2048 * 7680;
  constexpr int QSTR = 2064;
  LAS float* wl = (LAS float*)(lds + 32 * QSTR);
  float* scr = P.r2() + (size_t)blockIdx.x * 32 * 2048;
  __syncthreads();
#pragma unroll
  for (int i = 0; i < 8; ++i) {
    const int c = tid + 512 * i, row = c >> 7, ch = c & 127;
    *(LAS u32x4*)(lds + row * QSTR + ch * 16) = *(const u32x4*)(cd + (size_t)(tq0 + row) * 7680 + 6144 + ch * 8);
  }
  { const int row = tid >> 4, hi = tid & 15; wl[tid] = P.small()[(size_t)(b * 2048 + tq0 + row) * 256 + 96 + hi] * 0.03125f; }
  __syncthreads();
  const int tq = tq0 + r;
#pragma unroll 1
  for (int kt = w; kt <= qb; kt += 8) {
    const int k0 = kt * 32;
    bf16x8 kf[4];
#pragma unroll
    for (int s = 0; s < 4; ++s) kf[s] = *(const bf16x8*)(cd + (size_t)(k0 + r) * 7680 + 7424 + 16 * s + 8 * h);
    f32x16 sc = zero16();
#pragma unroll 2
    for (int hi = 0; hi < 16; ++hi) {
      const float wv_hi = wl[r * 16 + hi];
      f32x16 acc = zero16();
#pragma unroll
      for (int s = 0; s < 4; ++s) {
        const bf16x8 qf = *(const LAS bf16x8*)(lds + r * QSTR + (hi * 64 + 16 * s + 8 * h) * 2);
        acc = mfma32(kf[s], qf, acc);
      }
#pragma unroll
      for (int i = 0; i < 16; ++i) sc[i] += wv_hi * fmaxf(acc[i], 0.f);
    }
#pragma unroll
    for (int g = 0; g < 4; ++g) {
      f32x4 o4;
#pragma unroll
      for (int j = 0; j < 4; ++j) { const int key = k0 + 8 * g + 4 * h + j; o4[j] = key > tq ? -__builtin_inff() : sc[4 * g + j]; }
      *(f32x4*)(scr + (size_t)r * 2048 + k0 + 8 * g + 4 * h) = o4;
    }
  }
  __syncthreads();
  if (tq0 < 256) {
#pragma unroll 1
    for (int rr = 0; rr < 4; ++rr) {
      const int t = tq0 + 4 * w + rr, nvalid = t + 1;
      unsigned long long* mout = (unsigned long long*)(P.mask() + (size_t)(b * 2048 + t) * 64);
#pragma unroll
      for (int i = 0; i < 32; ++i) { const unsigned long long bal = __ballot(64 * i + lane < nvalid); if (lane == 0) mout[i] = bal; }
    }
  } else {
    unsigned u[4][32]; unsigned thr[4]; int cge[4]; bool act[4];
#pragma unroll
    for (int rr = 0; rr < 4; ++rr) {
      const int row = 4 * w + rr, nvalid = tq0 + row + 1;
#pragma unroll
      for (int i = 0; i < 32; ++i) { const int s = 64 * i + lane; const float f = scr[(size_t)row * 2048 + s]; u[rr][i] = (s < nvalid) ? ord_key(f) : 0u; }
      thr[rr] = 0u; cge[rr] = nvalid; act[rr] = true;
    }
#pragma unroll 1
    for (int bit = 31; bit >= 0; --bit) {
      if (!(act[0] || act[1] || act[2] || act[3])) break;
#pragma unroll
      for (int rr = 0; rr < 4; ++rr) {
        const unsigned cand = thr[rr] | (1u << bit);
        int cl = 0;
#pragma unroll
        for (int i = 0; i < 32; ++i) cl += (u[rr][i] >= cand) ? 1 : 0;
        int cnt = 0;
#pragma unroll
        for (int k = 0; k < 6; ++k) cnt += __popcll(__ballot((cl >> k) & 1)) << k;
        const bool take = act[rr] && cnt >= 256;
        thr[rr] = take ? cand : thr[rr]; cge[rr] = take ? cnt : cge[rr]; act[rr] = act[rr] && !(take && cnt == 256);
      }
    }
#pragma unroll
    for (int rr = 0; rr < 4; ++rr) {
      const int t = tq0 + 4 * w + rr, nvalid = t + 1, nslots = (nvalid + 63) >> 6;
      unsigned long long* mout = (unsigned long long*)(P.mask() + (size_t)(b * 2048 + t) * 64);
      const unsigned th = thr[rr];
      if (cge[rr] == 256) {
#pragma unroll
        for (int i = 0; i < 32; ++i) { const unsigned long long bal = __ballot(u[rr][i] >= th && u[rr][i] != 0u); if (lane == 0) mout[i] = (i < nslots) ? bal : 0ull; }
      } else {
        int cgt = 0;
#pragma unroll
        for (int i = 0; i < 32; ++i) cgt += __popcll(__ballot(u[rr][i] > th));
        int need = 256 - cgt;
#pragma unroll
        for (int i = 0; i < 32; ++i) {
          const unsigned long long beq = __ballot(u[rr][i] == th && th != 0u);
          const int rank = __popcll(beq & ((1ull << lane) - 1ull));
          const bool sel = (u[rr][i] > th) || ((u[rr][i] == th) && rank < need);
          const unsigned long long bal = __ballot(sel);
          need -= __popcll(beq); if (need < 0) need = 0;
          if (lane == 0) mout[i] = (i < nslots) ? bal : 0ull;
        }
      }
    }
  }
}

DI unsigned off_b(unsigned row, unsigned ch) { return 256u * row + 16u * (ch ^ (((row & 3) << 2) | ((row >> 2) & 3))); }

DI void ssd_conv_pass(const Params& P) {
  const int tid = mk_tid(P.wv), w = tid >> 6, lane = tid & 63;
  const bf16_t* cd = P.big();
  if (tid < 384) {
    const int col = tid * 8, r0 = blockIdx.x * 64, s0 = r0 & 2047;
    float wgt[4][8], bias[8];
#pragma unroll
    for (int j = 0; j < 4; ++j) { const f32x4 w0 = *(const f32x4*)(P.cd_conv_w + (size_t)j * 3072 + col), w1 = *(const f32x4*)(P.cd_conv_w + (size_t)j * 3072 + col + 4);
#pragma unroll
      for (int e = 0; e < 4; ++e) { wgt[j][e] = w0[e]; wgt[j][4 + e] = w1[e]; } }
    { const f32x4 b0 = *(const f32x4*)(P.cd_conv_b + col), b1 = *(const f32x4*)(P.cd_conv_b + col + 4);
#pragma unroll
      for (int e = 0; e < 4; ++e) { bias[e] = b0[e]; bias[4 + e] = b1[e]; } }
    u32x4 h0 = {0u, 0u, 0u, 0u}, h1 = h0, h2 = h0;
    if (s0 >= 3) { h0 = *(const u32x4*)(cd + (size_t)(r0 - 3) * 7680 + 2048 + col); h1 = *(const u32x4*)(cd + (size_t)(r0 - 2) * 7680 + 2048 + col); h2 = *(const u32x4*)(cd + (size_t)(r0 - 1) * 7680 + 2048 + col); }
#pragma unroll 1
    for (int rb = 0; rb < 64; rb += 8) {
      u32x4 in[8];
#pragma unroll
      for (int k = 0; k < 8; ++k) in[k] = *(const u32x4*)(cd + (size_t)(r0 + rb + k) * 7680 + 2048 + col);
#pragma unroll
      for (int k = 0; k < 8; ++k) {
        const u32x4 x3 = in[k];
        float acc[8];
#pragma unroll
        for (int e = 0; e < 8; ++e) acc[e] = bias[e];
        const u32x4 xs[4] = {h0, h1, h2, x3};
#pragma unroll
        for (int j = 0; j < 4; ++j) {
          acc[0] += wgt[j][0] * bflo(xs[j].x); acc[1] += wgt[j][1] * bfhi(xs[j].x); acc[2] += wgt[j][2] * bflo(xs[j].y); acc[3] += wgt[j][3] * bfhi(xs[j].y);
          acc[4] += wgt[j][4] * bflo(xs[j].z); acc[5] += wgt[j][5] * bfhi(xs[j].z); acc[6] += wgt[j][6] * bflo(xs[j].w); acc[7] += wgt[j][7] * bfhi(xs[j].w);
        }
#pragma unroll
        for (int e = 0; e < 8; ++e) acc[e] = siluf(acc[e]);
        pg8::store8bf(P.xc() + (size_t)(r0 + rb + k) * 3072 + col, acc);
        h0 = h1; h1 = h2; h2 = x3;
      }
    }
  } else {
    for (int k = w - 6; k < 16; k += 2) {
      const int wt = blockIdx.x * 16 + k;
      const int head = wt & 31, bc = wt >> 5, b = bc >> 4, c = bc & 15;
      const float a_h = -__expf(P.cd_a_log[head]), dtbias = P.cd_dt_bias[head];
      const size_t tr = (size_t)b * 2048 + c * 128 + 2 * lane;
      float d0 = P.small()[tr * 256 + 64 + head] + dtbias, d1 = P.small()[(tr + 1) * 256 + 64 + head] + dtbias;
      d0 = d0 > 20.f ? d0 : log1pf(__expf(d0)); d1 = d1 > 20.f ? d1 : log1pf(__expf(d1));
      const float a0 = d0 * a_h, a1 = d1 * a_h;
      float incl = a0 + a1;
#pragma unroll
      for (int o = 1; o < 64; o <<= 1) { const float up = __int_as_float(__builtin_amdgcn_ds_bpermute(((lane - o) & 63) << 2, __float_as_int(incl))); if (lane >= o) incl += up; }
      const size_t o2 = ((size_t)b * 32 + head) * 2048 + c * 128 + 2 * lane;
      *(f32x2*)(P.dtb() + o2) = (f32x2){d0, d1};
      *(f32x2*)(P.csb() + o2) = (f32x2){incl - a1, incl};
    }
  }
}

DI void ssd_item(const Params& P, LAS unsigned char* lds, int item) {
  const int b = item >> 5, head = item & 31, g = head >> 3;
  const int tid = mk_tid(P.wv), w = tid >> 6, lane = tid & 63, r = lane & 31, h = lane >> 5;
  const int lb = w & 3, pb = w >> 2;
  LAS unsigned char* CI = lds;
  LAS unsigned char* BI = lds + 32768;
  LAS unsigned char* XDT = lds + 65536;
  LAS unsigned char* XDW = lds + 90112;
  LAS unsigned char* XR = lds + 114688;
  LAS float* s_dt = (LAS float*)(lds + 139264);
  LAS float* s_cs = s_dt + 128;
  LAS float* s_ecs = s_dt + 256;
  LAS unsigned char* EX = lds + 141312;
  const float dsk = P.cd_d_skip[head];
  const bf16_t* cd = P.big() + (size_t)b * 2048 * 7680;
  const bf16_t* xc = P.xc() + (size_t)b * 2048 * 3072;
  const float* dtp = P.dtb() + ((size_t)b * 32 + head) * 2048;
  const float* csp = P.csb() + ((size_t)b * 32 + head) * 2048;
  f32x16 state = zero16();
  u32x4 rx[2], rb[4], rc[4]; float rdt[2], rcs[2], rlast;
  auto issue = [&](int c) {
    const int t0 = c * 128;
#pragma unroll
    for (int k = 0; k < 2; ++k) { const int row = (tid >> 3) + 64 * k; rx[k] = *(const u32x4*)(xc + (size_t)(t0 + row) * 3072 + head * 64 + (tid & 7) * 8); rdt[k] = dtp[t0 + row]; rcs[k] = csp[t0 + row]; }
#pragma unroll
    for (int k = 0; k < 4; ++k) { const int row = (tid >> 4) + 32 * k; rb[k] = *(const u32x4*)(xc + (size_t)(t0 + row) * 3072 + 2048 + g * 128 + (tid & 15) * 8); rc[k] = *(const u32x4*)(xc + (size_t)(t0 + row) * 3072 + 2560 + g * 128 + (tid & 15) * 8); }
    rlast = csp[t0 + 127];
  };
  __syncthreads();
#pragma unroll
  for (int s2 = 0; s2 < 2; ++s2) *(LAS u32x4*)(EX + (w * 2 + s2) * 1024 + lane * 16) = (u32x4){0u, 0u, 0u, 0u};
  issue(0);
  for (int c = 0; c < 16; ++c) {
    const int t0 = c * 128;
    __syncthreads();
    const float cs_last = rlast;
#pragma unroll
    for (int k = 0; k < 2; ++k) {
      const int row = (tid >> 3) + 64 * k, grp = tid & 7;
      const float dt = rdt[k], dw = dt * __expf(cs_last - rcs[k]);
      const float x[8] = {bflo(rx[k].x), bfhi(rx[k].x), bflo(rx[k].y), bfhi(rx[k].y), bflo(rx[k].z), bfhi(rx[k].z), bflo(rx[k].w), bfhi(rx[k].w)};
      u32x4 bq, cq;
      bq.x = pk2(x[0] * dt, x[1] * dt); bq.y = pk2(x[2] * dt, x[3] * dt); bq.z = pk2(x[4] * dt, x[5] * dt); bq.w = pk2(x[6] * dt, x[7] * dt);
      cq.x = pk2(x[0] * dw, x[1] * dw); cq.y = pk2(x[2] * dw, x[3] * dw); cq.z = pk2(x[4] * dw, x[5] * dw); cq.w = pk2(x[6] * dw, x[7] * dw);
      *(LAS u32x4*)(XR + row * 192 + grp * 16) = rx[k]; *(LAS u32x4*)(XDT + row * 192 + grp * 16) = bq; *(LAS u32x4*)(XDW + row * 192 + grp * 16) = cq;
      if (grp == 0) { s_dt[row] = dt; s_cs[row] = rcs[k]; s_ecs[row] = __expf(rcs[k]); }
    }
#pragma unroll
    for (int k = 0; k < 4; ++k) { const int row = (tid >> 4) + 32 * k; *(LAS u32x4*)(BI + off_b(row, tid & 15)) = rb[k]; *(LAS u32x4*)(CI + off_b(row, tid & 15)) = rc[k]; }
    __syncthreads();
    if (c + 1 < 16) issue(c + 1);
    f32x16 y = zero16();
    const float cs_l = s_cs[32 * lb + r];
    const int xtr = (4 * h + ((lane & 15) >> 2)) * 192 + (32 * pb + 16 * ((lane >> 4) & 1) + 4 * (lane & 3)) * 2;
    for (int sb = 0; sb <= lb; ++sb) {
      f32x16 X = zero16();
#pragma unroll
      for (int ks = 0; ks < 8; ++ks) {
        const bf16x8 af = *(const LAS bf16x8*)(BI + off_b(32 * sb + r, 2 * ks + h));
        const bf16x8 bf = *(const LAS bf16x8*)(CI + off_b(32 * lb + r, 2 * ks + h));
        X = mfma32(af, bf, X);
      }
#pragma unroll
      for (int q = 0; q < 4; ++q) {
        const f32x4 cs4 = *(const LAS f32x4*)(s_cs + 32 * sb + 8 * q + 4 * h);
#pragma unroll
        for (int j = 0; j < 4; ++j) {
          const int s = 32 * sb + 8 * q + 4 * h + j, l = 32 * lb + r;
          const float dec = __expf(cs_l - cs4[j]);
          X[4 * q + j] = (s <= l) ? X[4 * q + j] * dec : 0.f;
        }
      }
#pragma unroll
      for (int s2 = 0; s2 < 2; ++s2) {
        const bf16x8 xa = pack8(X, s2);
        const bf16x8 xb = tr_pair(XDT + xtr + (32 * sb + 16 * s2) * 192, 8 * 192);
        y = mfma32(xa, xb, y);
      }
    }
    {
      f32x16 acc2 = zero16();
#pragma unroll
      for (int nb = 0; nb < 4; ++nb)
#pragma unroll
        for (int s2 = 0; s2 < 2; ++s2) {
          const u32x2 lo = *(const LAS u32x2*)(CI + off_b(32 * lb + r, 4 * nb + 2 * s2) + 8 * h);
          const u32x2 hi = *(const LAS u32x2*)(CI + off_b(32 * lb + r, 4 * nb + 2 * s2 + 1) + 8 * h);
          const u32x4 a4 = {lo.x, lo.y, hi.x, hi.y};
          const bf16x8 sf = *(const LAS bf16x8*)(EX + ((nb + 4 * pb) * 2 + s2) * 1024 + lane * 16);
          acc2 = mfma32(__builtin_bit_cast(bf16x8, a4), sf, acc2);
        }
#pragma unroll
      for (int q = 0; q < 4; ++q) {
        const f32x4 e4 = *(const LAS f32x4*)(s_ecs + 32 * lb + 8 * q + 4 * h);
#pragma unroll
        for (int j = 0; j < 4; ++j) y[4 * q + j] += e4[j] * acc2[4 * q + j];
      }
    }
    {
      const int p = 32 * pb + r;
#pragma unroll
      for (int i = 0; i < 16; ++i) {
        const int l = 32 * lb + crow(i, h);
        const float xv = bf2f(*(const LAS unsigned short*)(XR + l * 192 + p * 2));
        const size_t t = (size_t)(b * 2048 + t0 + l);
        const float v = y[i] + xv * dsk;
        P.mixed()[t * 3072 + head * 64 + p] = (bf16_t)(pk2(v, 0.f) & 0xffffu);
      }
    }
    {
      const float el = __expf(cs_last);
#pragma unroll
      for (int i = 0; i < 16; ++i) state[i] *= el;
      const int q4 = (lane & 15) >> 2, p4 = lane & 3, blk = (lane >> 4) & 1;
      const int xtn = (8 * h + q4) * 192 + (32 * pb + 16 * blk + 4 * p4) * 2;
#pragma unroll
      for (int ks = 0; ks < 8; ++ks) {
        const s16x4 a_lo = __builtin_amdgcn_ds_read_tr16_b64_v4i16((LAS s16x4*)(BI + off_b(16 * ks + 8 * h + q4, 4 * lb + 2 * blk + (p4 >> 1)) + 8 * (p4 & 1)));
        const s16x4 a_hi = __builtin_amdgcn_ds_read_tr16_b64_v4i16((LAS s16x4*)(BI + off_b(16 * ks + 8 * h + 4 + q4, 4 * lb + 2 * blk + (p4 >> 1)) + 8 * (p4 & 1)));
        const bf16x8 af = __builtin_shufflevector(a_lo, a_hi, 0, 1, 2, 3, 4, 5, 6, 7);
        const bf16x8 bf = tr_pair(XDW + xtn + (16 * ks) * 192, 4 * 192);
        state = mfma32(af, bf, state);
      }
    }
    __syncthreads();
#pragma unroll
    for (int s2 = 0; s2 < 2; ++s2) { const bf16x8 sf = pack8(state, s2); *(LAS bf16x8*)(EX + (w * 2 + s2) * 1024 + lane * 16) = sf; }
  }
}

DI void ssd_norm_rows(const Params& P, int row0, int nrows) {
  const int tid = mk_tid(P.wv), w = tid >> 6, lane = tid & 63;
  for (int rr = w; rr < nrows; rr += 16) {
    u32x4 in[2][4], zz[2][4];
#pragma unroll
    for (int a = 0; a < 2; ++a)
#pragma unroll
      for (int i = 0; i < 4; ++i) {
        const int c = 512 * i + 8 * lane;
        in[a][i] = *(const u32x4*)(P.mixed() + (size_t)(row0 + rr + 8 * a) * 3072 + c);
        zz[a][i] = *(const u32x4*)(P.big() + (size_t)(row0 + rr + 8 * a) * 7680 + c);
      }
    float v[2][4][8], ss[2][4];
#pragma unroll
    for (int a = 0; a < 2; ++a)
#pragma unroll
      for (int i = 0; i < 4; ++i) {
        const u32x4 x = in[a][i], z = zz[a][i];
        const float t8[8] = {bflo(x.x) * bflo(z.x), bfhi(x.x) * bfhi(z.x), bflo(x.y) * bflo(z.y), bfhi(x.y) * bfhi(z.y), bflo(x.z) * bflo(z.z), bfhi(x.z) * bfhi(z.z), bflo(x.w) * bflo(z.w), bfhi(x.w) * bfhi(z.w)};
        float s = 0.f;
#pragma unroll
        for (int j = 0; j < 8; ++j) { v[a][i][j] = t8[j]; s += t8[j] * t8[j]; }
        ss[a][i] = s;
      }
#pragma unroll
    for (int off = 32; off >= 1; off >>= 1)
#pragma unroll
      for (int a = 0; a < 2; ++a)
#pragma unroll
        for (int i = 0; i < 4; ++i) ss[a][i] += shx(ss[a][i], off, lane);
#pragma unroll
    for (int a = 0; a < 2; ++a)
#pragma unroll
      for (int i = 0; i < 4; ++i) {
        const int c = 512 * i + 8 * lane;
        const float rs = rsqrtf(ss[a][i] * (1.0f / 512.0f) + EPSN);
        const f32x4 g0 = *(const f32x4*)(P.cd_ssm_norm + c), g1 = *(const f32x4*)(P.cd_ssm_norm + c + 4);
        float o[8];
#pragma unroll
        for (int j = 0; j < 4; ++j) { o[j] = v[a][i][j] * rs * g0[j]; o[4 + j] = v[a][i][4 + j] * rs * g1[j]; }
        pg8::store8bf(P.mixed() + (size_t)(row0 + rr + 8 * a) * 3072 + c, o);
      }
  }
}
DI int ord_i(float f) { const int b = __float_as_int(f); return b ^ ((b >> 31) & 0x7fffffff); }
DI float unord_i(int k) { return __int_as_float(k ^ ((k >> 31) & 0x7fffffff)); }
#define MERGE16(A, B) do { _Pragma("unroll") for (int _i = 0; _i < 16; ++_i) A[_i] = max(A[_i], B[15 - _i]); \
    _Pragma("unroll") for (int _d = 8; _d >= 1; _d >>= 1) _Pragma("unroll") for (int _i = 0; _i < 16; ++_i) if ((_i & _d) == 0) { const int _a = A[_i], _b = A[_i + _d]; A[_i] = max(_a, _b); A[_i + _d] = min(_a, _b); } } while (0)
#define INS16(L, xin) do { int _x = (xin); _Pragma("unroll") for (int _i = 0; _i < 16; ++_i) { const int _hi = max(L[_i], _x); _x = min(L[_i], _x); L[_i] = _hi; } } while (0)

#define SORT16(A) do { _Pragma("unroll") for (int _k = 2; _k <= 16; _k <<= 1) _Pragma("unroll") for (int _j = _k >> 1; _j > 0; _j >>= 1) _Pragma("unroll") for (int _i = 0; _i < 16; ++_i) { \
    const int _l = _i ^ _j; if (_l > _i) { const int _a = A[_i], _b = A[_l]; const bool _d = (_i & _k) == 0; A[_i] = _d ? max(_a, _b) : min(_a, _b); A[_l] = _d ? min(_a, _b) : max(_a, _b); } } } while (0)

DI void peer_partA2(const Params& P, LAS unsigned char* lds, int item, int layer) {
  const int tid = mk_tid(P.wv), w = tid >> 6, lane = tid & 63, r = lane & 31, h = lane >> 5;
  LAS unsigned short* EID = (LAS unsigned short*)(lds + 8192);
  LAS float* GATE = (LAS float*)(lds + 24576);
  __syncthreads();
  int L01[2][2][16];
#pragma unroll
  for (int c = 0; c < 2; ++c) {
    bf16x8 bq[2][8];
#pragma unroll
    for (int tl = 0; tl < 2; ++tl) {
      const bf16_t* qp = P.r1() + (size_t)((item + 256 * tl) * 32 + r) * 2048;
#pragma unroll
      for (int s = 0; s < 8; ++s) bq[tl][s] = *(const bf16x8*)(qp + (2 * w + c) * 128 + 16 * s + 8 * h);
    }
    const bf16_t* kbase = P.keys() + ((size_t)((layer * 8 + w) * 2 + c) * 128) * 128;
    int L[2][16];
#pragma unroll
    for (int tl = 0; tl < 2; ++tl)
#pragma unroll
      for (int i = 0; i < 16; ++i) L[tl][i] = (int)0x80000000;
#pragma unroll 1
    for (int kb = 0; kb < 4; ++kb) {
      f32x16 st0 = zero16(), st1 = zero16();
#pragma unroll
      for (int s = 0; s < 8; ++s) {
        const bf16x8 kf = *(const bf16x8*)(kbase + (size_t)(32 * kb + r) * 128 + 16 * s + 8 * h);
        st0 = mfma32(kf, bq[0][s], st0); st1 = mfma32(kf, bq[1][s], st1);
      }
#pragma unroll
      for (int tl = 0; tl < 2; ++tl) {
        int N[16];
#pragma unroll
        for (int i = 0; i < 16; ++i) { const int key = 32 * kb + crow(i, h); N[i] = (ord_i(tl ? st1[i] : st0[i]) & ~127) | (127 - key); }
        SORT16(N);
        MERGE16(L[tl], N);
      }
    }
#pragma unroll
    for (int tl = 0; tl < 2; ++tl) {
      LAS unsigned char* IDX = lds + (tl ? 61696 : 0);
      int M[16];
#pragma unroll
      for (int i = 0; i < 16; ++i) M[i] = shxi(L[tl][i], 32, lane);
#pragma unroll
      for (int i = 0; i < 16; ++i) L[tl][i] = max(L[tl][i], M[15 - i]);
#pragma unroll
      for (int d = 8; d >= 1; d >>= 1)
#pragma unroll
        for (int i = 0; i < 16; ++i) if ((i & d) == 0) { const int a = L[tl][i], bb = L[tl][i + d]; L[tl][i] = max(a, bb); L[tl][i + d] = min(a, bb); }
#pragma unroll
      for (int i = 0; i < 16; ++i) { L01[tl][c][i] = L[tl][i]; IDX[(r * 8 + w) * 32 + c * 16 + i] = (unsigned char)(127 - (L[tl][i] & 127)); }
    }
  }
#pragma unroll
  for (int tl = 0; tl < 2; ++tl) {
    const int tid = mk_tid(P.wv), w = tid >> 6, lane = tid & 63, r = lane & 31, h = lane >> 5;
    LAS unsigned char* IDX = lds + (tl ? 61696 : 0);
    int W[16], C1[16], C2[16], X0 = 0, X1 = 0;
    const float a0 = unord_i(L01[tl][0][0] & ~127);
#pragma unroll
    for (int j = 0; j < 16; ++j) W[j] = (ord_i(a0 + unord_i(L01[tl][1][j] & ~127)) & ~255) | (255 - j);
    {
      int n = 0;
#pragma unroll
      for (int i = 1; i < 16; ++i) {
        const float a = unord_i(L01[tl][0][i] & ~127);
#pragma unroll
        for (int j = 0; j < 16; ++j) if ((i + 1) * (j + 1) <= 16) {
          const float sum = a + unord_i(L01[tl][1][j] & ~127);
          const int key = (ord_i(sum) & ~255) | (255 - (i * 16 + j));
          if (n < 16) C1[n] = key; else if (n < 32) C2[n - 16] = key; else if (n == 32) X0 = key; else X1 = key;
          ++n;
        }
      }
    }
    SORT16(C1); SORT16(C2);
    MERGE16(W, C1); MERGE16(W, C2);
    INS16(W, X0); INS16(W, X1);
    const float v0 = unord_i(W[0] & ~255);
    float e[16], es = 0.f;
#pragma unroll
    for (int k = 0; k < 16; ++k) { e[k] = __expf(unord_i(W[k] & ~255) - v0); es += e[k]; }
    const float inv = 1.0f / es;
#pragma unroll
    for (int k = 0; k < 16; ++k) if ((k >> 3) == h) {
      const int pl = 255 - (W[k] & 255), ci = pl >> 4, cj = pl & 15;
      const int i0 = IDX[(r * 8 + w) * 32 + ci], i1 = IDX[(r * 8 + w) * 32 + 16 + cj];
      EID[(32 * tl + r) * 128 + w * 16 + k] = (unsigned short)(i0 * 128 + i1);
      GATE[(32 * tl + r) * 128 + w * 16 + k] = e[k] * inv;
    }
  }
}

#ifndef PEER_SYNC
#define PEER_SYNC 1
#endif
DI void peer_sort_bands(const Params& P, LAS unsigned char* lds, int layer) {
  const int tid = mk_tid(P.wv), w = tid >> 6, lane = tid & 63;
  LAS float* USC = (LAS float*)(lds + 61696);
  const float* usc = P.usc() + layer * 16384;
  const float* vsc = P.vsc() + layer * 16384;
  LAS unsigned short* EID = (LAS unsigned short*)(lds + 8192);
  LAS float* GATE = (LAS float*)(lds + 24576);
  const unsigned long long lt = (1ull << lane) - 1ull;
#pragma unroll 1
  for (int it = 0; it < 16; ++it) {
    const int tt = it >> 1, sh = (it & 1) ? 10 : 6;
    const int tok = 32 * (tt >> 2) + 4 * w + (tt & 3);
    const int id0 = EID[tok * 128 + lane], id1 = EID[tok * 128 + 64 + lane];
    const float g0 = GATE[tok * 128 + lane], g1 = GATE[tok * 128 + 64 + lane];
    const int dg0 = (id0 >> sh) & 15, dg1 = (id1 >> sh) & 15;
    float us0 = 0.f, us1 = 0.f, vs0 = 1.f, vs1 = 1.f;
    if (it & 1) { us0 = usc[id0]; us1 = usc[id1]; vs0 = vsc[id0]; vs1 = vsc[id1]; }
    int base = 0, p0 = 0, p1 = 0;
#pragma unroll
    for (int bnd = 0; bnd < 16; ++bnd) {
      const unsigned long long b0 = __ballot(dg0 == bnd), b1 = __ballot(dg1 == bnd);
      if (dg0 == bnd) p0 = base + __popcll(b0 & lt);
      if (dg1 == bnd) p1 = base + __popcll(b0) + __popcll(b1 & lt);
      base += __popcll(b0) + __popcll(b1);
    }
    EID[tok * 128 + p0] = (unsigned short)id0; EID[tok * 128 + p1] = (unsigned short)id1;
    GATE[tok * 128 + p0] = g0 * vs0; GATE[tok * 128 + p1] = g1 * vs1;
    if (it & 1) { USC[tok * 128 + p0] = us0; USC[tok * 128 + p1] = us1; }
  }
}

#define ISSUE_ROW(TAB, RA, RB, IDS) do { const unsigned _ro = (unsigned)(IDS) * (unsigned)TROW; \
      RA = __builtin_amdgcn_raw_buffer_load_b128(TAB, 16 * lane, _ro, 0); RB = __builtin_amdgcn_raw_buffer_load_b64(TAB, 8 * lane + 1024, _ro, 0); } while (0)
DI void peer_usweep(const Params& P, LAS unsigned char* lds, int layer, int c, GridBar& gb) {
  const int tid = mk_tid(P.wv), w = tid >> 6, lane = tid & 63;
  LAS unsigned short* EID = (LAS unsigned short*)(lds + 8192);
  LAS float* GATE = (LAS float*)(lds + 24576);
  const __amdgpu_buffer_rsrc_t utab = __builtin_amdgcn_make_buffer_rsrc((void*)(P.utab() + (size_t)layer * 16384 * TROW), 0, 0x7fffffff, 0x00020000);
  const __amdgpu_buffer_rsrc_t vtab = __builtin_amdgcn_make_buffer_rsrc((void*)(P.vtab() + (size_t)layer * 16384 * TROW), 0, 0x7fffffff, 0x00020000);
  LAS float* USC = (LAS float*)(lds + 61696);
  const float* gffn = P.norm_ffn + layer * 2048;
  const int qsel = ((lane >> 5) & 1) + 2 * ((lane >> 4) & 1);
  {
    h16x2 xq[8][16];
    const int lx = lane_id();
#pragma unroll
    for (int tt = 0; tt < 8; ++tt) {
      const size_t t = (size_t)(c + 256 * (tt >> 2)) * 32 + 4 * w + (tt & 3);
      const float rs = rsqrtf(wave_sum(lane < 32 ? P.ssqp()[t * 32 + lane] : 0.f, lane) * (1.0f / 2048.0f) + EPSN);
#pragma unroll
      for (int i = 0; i < 4; ++i) {
        const int cc = 512 * i + 8 * lx;
        const u32x4 hb = *(const u32x4*)(P.xb() + t * 2048 + cc);
        const f32x4 a = {__uint_as_float(hb.x << 16), __uint_as_float(hb.x & 0xffff0000u), __uint_as_float(hb.y << 16), __uint_as_float(hb.y & 0xffff0000u)};
        const f32x4 b = {__uint_as_float(hb.z << 16), __uint_as_float(hb.z & 0xffff0000u), __uint_as_float(hb.w << 16), __uint_as_float(hb.w & 0xffff0000u)};
        const f32x4 g0 = *(const f32x4*)(gffn + cc), g1 = *(const f32x4*)(gffn + cc + 4);
#pragma unroll
        for (int j = 0; j < 4; ++j) {
          const _Float16 v0 = (_Float16)(a[j] * rs * g0[j]), v1 = (_Float16)(b[j] * rs * g1[j]);
          if (i < 2) { xq[tt][8 * i + j].x = v0; xq[tt][8 * i + 4 + j].x = v1; } else { xq[tt][8 * i + j - 16].y = v0; xq[tt][8 * i + 4 + j - 16].y = v1; }
        }
      }
    }
    gb.xsync();
    u32x4 ua[2][4]; u32x2 ub[2][4]; float usf[2];
#pragma unroll
    for (int st = 0; st < 2; ++st) { const int eb0 = (4 * w + st) * 128;
      usf[st] = USC[eb0 + qsel];
#pragma unroll
      for (int q = 0; q < 4; ++q) ISSUE_ROW(utab, ua[st][q], ub[st][q], __builtin_amdgcn_readfirstlane((int)EID[eb0 + q])); }
    float dp0 = 0.f, dp1 = 0.f, dp2 = 0.f, dp3 = 0.f, usf_p = 0.f; int ebp = -1;
    const bool h32 = (lane & 32) != 0, h16 = (lane & 16) != 0;
#pragma unroll 1
    for (int j = 0; j < 32; ++j) {
#pragma unroll
      for (int tt = 0; tt < 8; ++tt) {
        {
          const int eb = (32 * (tt >> 2) + 4 * w + (tt & 3)) * 128 + 4 * j;
          const int st = tt & 1;
          const int ebn = (tt < 6) ? (32 * ((tt + 2) >> 2) + 4 * w + ((tt + 2) & 3)) * 128 + 4 * j : (4 * w + tt - 6) * 128 + 4 * min(j + 1, 31);
          const u32x2 idn = *(const LAS u32x2*)(EID + ebn);
          const float gprev = GATE[max(ebp, 0) + qsel];
          const float usf_c = usf[st];
          usf[st] = USC[ebn + qsel];
          float d4[4];
          float r0 = 0.f, r1 = 0.f, rd = 0.f, c8 = 0.f;
#pragma unroll
          for (int q = 0; q < 4; ++q) {
            if (q == 0) { r0 = shx(h32 ? dp0 : dp1, 32, lane); r1 = shx(h32 ? dp2 : dp3, 32, lane); }
            if (q == 1) { r0 += h32 ? dp1 : dp0; r1 += h32 ? dp3 : dp2; c8 = shx(h16 ? r0 : r1, 16, lane); }
            if (q == 2) { rd = (h16 ? r1 : r0) + c8; c8 = shx(rd, 8, lane); }
            if (q == 3) { rd += c8; c8 = shx(rd, 4, lane); }
            __builtin_amdgcn_sched_barrier(0);
            float da = 0.f, db = 0.f;
            const u32x6 pk = {ua[st][q].x, ua[st][q].y, ua[st][q].z, ua[st][q].w, ub[st][q].x, ub[st][q].y};
            const h16x32 f = __builtin_amdgcn_cvt_scalef32_pk32_f16_fp6(pk, 1.0f);
#pragma unroll
            for (int m = 0; m < 16; m += 2) {
              da = __builtin_amdgcn_fdot2((h16x2){f[2 * m], f[2 * m + 1]}, xq[tt][m], da, false);
              db = __builtin_amdgcn_fdot2((h16x2){f[2 * m + 2], f[2 * m + 3]}, xq[tt][m + 1], db, false);
            }
            float dq = da + db;
            { const int s2 = __builtin_amdgcn_readfirstlane((int)(q < 2 ? idn.x : idn.y));
              unsigned ro = (unsigned)((q & 1) ? (int)((unsigned)s2 >> 16) : (s2 & 0xffff)) * (unsigned)TROW;
              asm volatile("" : "+v"(dq), "+s"(ro));
              ua[st][q] = __builtin_amdgcn_raw_buffer_load_b128(utab, 16 * lane, ro, 0); ub[st][q] = __builtin_amdgcn_raw_buffer_load_b64(utab, 8 * lane + 1024, ro, 0); }
            d4[q] = dq;
            __builtin_amdgcn_sched_barrier(0);
          }
          {
            float d = rd + c8; d += shx(d, 2, lane); d += shx(d, 1, lane);
            d *= usf_p;
            const float u3 = 0.7978845608028654f * (d + 0.044715f * d * d * d);
            const float th = 1.0f - 2.0f * __builtin_amdgcn_rcpf(__expf(2.0f * u3) + 1.0f);
            const float act = 0.5f * d * (1.0f + th);
            if ((lane & 15) == 0 && ebp >= 0) GATE[ebp + qsel] = gprev * act;
          }
          dp0 = d4[0]; dp1 = d4[1]; dp2 = d4[2]; dp3 = d4[3]; usf_p = usf_c; ebp = eb;
        }
      }
    }
    {
      float k0 = h32 ? dp1 : dp0; k0 += shx(h32 ? dp0 : dp1, 32, lane);
      float k1 = h32 ? dp3 : dp2; k1 += shx(h32 ? dp2 : dp3, 32, lane);
      float d = h16 ? k1 : k0; d += shx(h16 ? k0 : k1, 16, lane);
      d += shx(d, 8, lane); d += shx(d, 4, lane); d += shx(d, 2, lane); d += shx(d, 1, lane);
      d *= usf_p;
      const float u3 = 0.7978845608028654f * (d + 0.044715f * d * d * d);
      const float th = 1.0f - 2.0f * __builtin_amdgcn_rcpf(__expf(2.0f * u3) + 1.0f);
      const float act = 0.5f * d * (1.0f + th);
      if ((lane & 15) == 0) GATE[ebp + qsel] *= act;
    }
  }
}

DI void peer_vsweep(const Params& P, LAS unsigned char* lds, int layer, int sidx, int c, GridBar& gb) {
  const int tid = mk_tid(P.wv), w = tid >> 6, lane = tid & 63;
  const int rb = 32 * sidx + 4 * w;
  const size_t tg = (size_t)(c + 256 * sidx) * 32 + 4 * w;
  LAS unsigned short* EID = (LAS unsigned short*)(lds + 8192);
  LAS float* GATE = (LAS float*)(lds + 24576);
  const __amdgpu_buffer_rsrc_t utab = __builtin_amdgcn_make_buffer_rsrc((void*)(P.utab() + (size_t)layer * 16384 * TROW), 0, 0x7fffffff, 0x00020000);
  const __amdgpu_buffer_rsrc_t vtab = __builtin_amdgcn_make_buffer_rsrc((void*)(P.vtab() + (size_t)layer * 16384 * TROW), 0, 0x7fffffff, 0x00020000);
  const float* usc = P.usc() + layer * 16384;
  const float* vsc = P.vsc() + layer * 16384;
  const float* gffn = P.norm_ffn + layer * 2048;
  const int qsel = ((lane >> 5) & 1) + 2 * ((lane >> 4) & 1);
  {
    f32x2 ac[4][16];
#pragma unroll
    for (int tt = 0; tt < 4; ++tt)
#pragma unroll
      for (int i = 0; i < 16; ++i) ac[tt][i] = (f32x2){0.f, 0.f};
    if (sidx == 0) gb.xsync(); else __syncthreads();
    u32x4 va[4]; u32x2 vb[4];
    f32x4 wcur;
    { const int eb0 = rb * 128;
      wcur = *(const LAS f32x4*)(GATE + eb0);
#pragma unroll
      for (int q = 0; q < 4; ++q) ISSUE_ROW(vtab, va[q], vb[q], __builtin_amdgcn_readfirstlane((int)EID[eb0 + q])); }
#pragma unroll 1
    for (int j = 0; j < 32; ++j) {
#pragma unroll
      for (int tt = 0; tt < 4; ++tt) {
        {
          const int ebn = (tt < 3) ? (rb + tt + 1) * 128 + 4 * j : rb * 128 + 4 * min(j + 1, 31);
          const u32x2 idn = *(const LAS u32x2*)(EID + ebn);
          const f32x4 wnext = *(const LAS f32x4*)(GATE + ebn);
#pragma unroll
          for (int q = 0; q < 4; ++q) {
            const float wq = wcur[q];
            const u32x6 pk = {va[q].x, va[q].y, va[q].z, va[q].w, vb[q].x, vb[q].y};
            const f32x32 f = __builtin_amdgcn_cvt_scalef32_pk32_f32_fp6(pk, 1.0f);
            { const int s2 = __builtin_amdgcn_readfirstlane((int)(q < 2 ? idn.x : idn.y));
              ISSUE_ROW(vtab, va[q], vb[q], (q & 1) ? (int)((unsigned)s2 >> 16) : (s2 & 0xffff)); }
#pragma unroll
            for (int m = 0; m < 16; ++m) ac[tt][m] = __builtin_elementwise_fma((f32x2){f[2 * m], f[2 * m + 1]}, (f32x2){wq, wq}, ac[tt][m]);
            asm volatile("" : "+v"(ac[tt][0]), "+v"(ac[tt][1]), "+v"(ac[tt][2]), "+v"(ac[tt][3]), "+v"(ac[tt][4]), "+v"(ac[tt][5]), "+v"(ac[tt][6]), "+v"(ac[tt][7]));
            asm volatile("" : "+v"(ac[tt][8]), "+v"(ac[tt][9]), "+v"(ac[tt][10]), "+v"(ac[tt][11]), "+v"(ac[tt][12]), "+v"(ac[tt][13]), "+v"(ac[tt][14]), "+v"(ac[tt][15]));
            __builtin_amdgcn_sched_barrier(0);
          }
          wcur = wnext;
        }
      }
    }
#undef ISSUE_ROW
#pragma unroll
    for (int tt = 0; tt < 4; ++tt) {
      const size_t t = tg + tt;
      const int lane = lane_id();
      float acc[32];
#pragma unroll
      for (int n = 0; n < 16; ++n) { acc[n] = ac[tt][n].x; acc[16 + n] = ac[tt][n].y; }
      float ss = 0.f;
#pragma unroll
      for (int i = 0; i < 4; ++i) {
        const int cc = 512 * i + 8 * lane;
        const u32x4 hb = *(const u32x4*)(P.xb() + t * 2048 + cc);
        const f32x4 a = {__uint_as_float(hb.x << 16), __uint_as_float(hb.x & 0xffff0000u), __uint_as_float(hb.y << 16), __uint_as_float(hb.y & 0xffff0000u)};
        const f32x4 b = {__uint_as_float(hb.z << 16), __uint_as_float(hb.z & 0xffff0000u), __uint_as_float(hb.w << 16), __uint_as_float(hb.w & 0xffff0000u)};
#pragma unroll
        for (int j = 0; j < 4; ++j) { acc[8 * i + j] += a[j]; acc[8 * i + 4 + j] += b[j]; }
#pragma unroll
        for (int j = 0; j < 8; ++j) ss += acc[8 * i + j] * acc[8 * i + j];
      }
      ss = wave_sum(ss, lane);
      if (layer == 0) {
#pragma unroll
        for (int i = 0; i < 4; ++i) {
          const int cc = 512 * i + 8 * lane;
          *(f32x4*)(P.hbuf() + t * 2048 + cc) = (f32x4){acc[8 * i], acc[8 * i + 1], acc[8 * i + 2], acc[8 * i + 3]};
          *(f32x4*)(P.hbuf() + t * 2048 + cc + 4) = (f32x4){acc[8 * i + 4], acc[8 * i + 5], acc[8 * i + 6], acc[8 * i + 7]};
          const float v[8] = {acc[8 * i], acc[8 * i + 1], acc[8 * i + 2], acc[8 * i + 3], acc[8 * i + 4], acc[8 * i + 5], acc[8 * i + 6], acc[8 * i + 7]};
          pg8::store8bf(P.xb() + t * 2048 + cc, v);
        }
        if (lane == 0) P.ssq2()[t] = ss;
      } else {
        const float rf = rsqrtf(ss * (1.0f / 2048.0f) + EPSN);
#pragma unroll
        for (int i = 0; i < 4; ++i) {
          const int cc = 512 * i + 8 * lane;
          const f32x4 g0 = *(const f32x4*)(P.norm_final + cc), g1 = *(const f32x4*)(P.norm_final + cc + 4);
          *(f32x4*)(P.out + t * 2048 + cc) = (f32x4){acc[8 * i] * rf * g0[0], acc[8 * i + 1] * rf * g0[1], acc[8 * i + 2] * rf * g0[2], acc[8 * i + 3] * rf * g0[3]};
          *(f32x4*)(P.out + t * 2048 + cc + 4) = (f32x4){acc[8 * i + 4] * rf * g1[0], acc[8 * i + 5] * rf * g1[1], acc[8 * i + 6] * rf * g1[2], acc[8 * i + 7] * rf * g1[3]};
        }
      }
    }
  }
}

DI void peer_phase(const Params& P, LAS unsigned char* lds, int layer, int c, GridBar& gb) {
  peer_partA2(P, lds, c, layer);
  __syncthreads();
  peer_sort_bands(P, lds, layer);
  peer_usweep(P, lds, layer, c, gb);
  peer_vsweep(P, lds, layer, 0, c, gb);
  peer_vsweep(P, lds, layer, 1, c, gb);
}
#define GBAR() gbar.sync()
__global__ void __launch_bounds__(512) hybrid_forward(Params Pk) {
  extern __shared__ __attribute__((aligned(16))) unsigned char lds_raw[];
  LAS unsigned char* lds = (LAS unsigned char*)lds_raw;
  cg::grid_group grid = cg::this_grid();
  Params P = Pk; P.wv = __builtin_amdgcn_readfirstlane((int)(threadIdx.x >> 6));
  LAS int* slot = (LAS int*)(lds + 163000);
  pg8::StaticOrder so;
  const int G = gridDim.x, c = blockIdx.x;

  GridBar gbar{P.ctr(), 0u, (unsigned)G, (volatile LAS unsigned*)(lds + 163008), P.wv};
  if (threadIdx.x < 2) gbar.st[threadIdx.x] = 0u;
  __syncthreads();
  gbar.post();
  phase_prep(P, lds);
  grid.sync();
  { so.init(T_TOK, 6144, G, c); pg8::Gemm g{P.xb(), P.w_ab_in(), T_TOK, 6144, 2048, 2048};
    pg8::EpiAbIn e{P.big(), P.ssq0(), P.rope()}; pg8::gemm_phase(lds, g, so, e, P.wv); }
  GBAR();
  phase_attn_ab(P, lds);
  GBAR();
  { so.init(T_TOK, 2048, G, c); pg8::Gemm g{P.mixed(), P.w_ab_out(), T_TOK, 2048, 2048, 2048};
    pg8::EpiRes e{P.x, P.hbuf(), P.xb(), P.ssqp()}; pg8::gemm_phase(lds, g, so, e, P.wv); }
  GBAR();
  { so.init(T_TOK, 2048, G, c); pg8::Gemm g{P.xb(), P.w_q0(), T_TOK, 2048, 2048, 2048};
    pg8::EpiScale<32> e{P.r1(), 2048, P.ssqp(), 1.0f / 2048.0f}; pg8::gemm_phase(lds, g, so, e, P.wv); }
  GBAR();
  peer_phase(P, lds, 0, c, gbar);
  GBAR();
  { so.init(T_TOK, 7680, G, c); pg8::Gemm g{P.xb(), P.w_cd_in(), T_TOK, 7680, 2048, 2048};
    pg8::EpiCdIn e{P.big(), P.ssq2(), P.small(), P.ssqc()}; pg8::gemm_phase(lds, g, so, e, P.wv); }
  if (c >= 128)
    for (;;) { const int k = next_item(P.ctr() + 2, slot, P.wv); if (k >= N_CVT_LATE) break; cvt_item(P, lds, N_CVT_ITEMS - N_CVT_LATE + k); }
  GBAR();
  { so.init(T_TOK, 2048, G, c); pg8::Gemm g{P.big() + 7168, P.w_kv(), T_TOK, 2048, 256, 7680};
    pg8::EpiScale<4> e{P.r1(), 2048, P.ssqc(), 1.0f / 256.0f}; pg8::gemm_phase(lds, g, so, e, P.wv); }
  ssd_conv_pass(P);
  for (;;) {
    const int item = next_item(P.ctr() + 1, slot, P.wv);
    if (item >= 512) break;
    dsa_index_item(P, lds, item);
  }
  GBAR();
  ssd_item(P, lds, c);
  dsa_attn_item(P, lds, c); dsa_attn_item(P, lds, 511 - c);
  GBAR();
  ssd_norm_rows(P, c * 64, 64);
  GBAR();
  { so.init(T_TOK, 2048, G, c); pg8::Gemm g{P.mixed(), P.w_cd_out(), T_TOK, 2048, 3072, 3072};
    pg8::EpiRes e{P.hbuf(), P.hbuf(), P.xb(), P.ssqp()}; pg8::gemm_phase(lds, g, so, e, P.wv); }
  GBAR();
  { so.init(T_TOK, 2048, G, c); pg8::Gemm g{P.xb(), P.w_q1(), T_TOK, 2048, 2048, 2048};
    pg8::EpiScale<32> e{P.r1(), 2048, P.ssqp(), 1.0f / 2048.0f}; pg8::gemm_phase(lds, g, so, e, P.wv); }
  GBAR();
  peer_phase(P, lds, 1, c, gbar);
}

extern "C" void kernel_launch(void* const* d_in, const int* in_sizes, int n_in, void* d_out, int out_size, void* d_ws, size_t ws_size, hipStream_t stream) {
  constexpr size_t kDynLds = 160 * 1024;
  static int grid_blocks = 0;
  if (!grid_blocks) {
    (void)hipFuncSetAttribute((const void*)hybrid_forward, hipFuncAttributeMaxDynamicSharedMemorySize, (int)kDynLds);
    int dev = 0, cus = 0, per_cu = 0;
    (void)hipGetDevice(&dev);
    (void)hipDeviceGetAttribute(&cus, hipDeviceAttributeMultiprocessorCount, dev);
    (void)hipOccupancyMaxActiveBlocksPerMultiprocessor(&per_cu, hybrid_forward, 512, kDynLds);
    if (per_cu < 1) fprintf(stderr, "occupancy query returned %d\n", per_cu);
    if (cus < 256) fprintf(stderr, "need 256 CUs, found %d\n", cus);
    grid_blocks = 256;
  }
  Params p{};
  const float* const* in = (const float* const*)d_in;
  p.x = in[0]; p.rel_table = in[1]; p.ab_w_in = in[2]; p.ab_w_out = in[3]; p.ab_lambda = in[4]; p.ab_a_norm = in[5]; p.ab_b_norm = in[6];
  p.cd_w_in = in[7]; p.cd_w_out = in[8]; p.cd_conv_w = in[9]; p.cd_conv_b = in[10]; p.cd_dt_bias = in[11]; p.cd_a_log = in[12]; p.cd_d_skip = in[13];
  p.cd_ssm_norm = in[14]; p.cd_kv_norm = in[15]; p.cd_w_uk = in[16]; p.cd_w_uv = in[17]; p.norm_mix = in[18]; p.norm_ffn = in[19];
  p.peer_w_q = in[20]; p.peer_keys = in[21]; p.peer_u = in[22]; p.peer_v = in[23]; p.norm_final = in[24];
  p.out = (float*)d_out;
  p.ws = (unsigned char*)d_ws; p.wv = 0; p.pad = 0;
  if (WS_TOTAL > ws_size) { fprintf(stderr, "workspace too small: need %zu have %zu\n", (size_t)WS_TOTAL, ws_size); return; }
  (void)hipMemsetAsync(p.ws + OFF_ctr, 0, 16384, stream);
  void* args[] = {&p};
  hipError_t e = hipLaunchCooperativeKernel((void*)hybrid_forward, dim3(grid_blocks), dim3(512), args, kDynLds, stream);
  if (e != hipSuccess) fprintf(stderr, "cooperative launch failed: %s (grid %d)\n", hipGetErrorString(e), grid_blocks);
}
```
